# Optimizing an MI355X kernel written in HIP

```python
import jax, jax.numpy as jnp
from jax import lax
import numpy as np

D_MODEL = 1024
BATCH = 8
SEQ = 4096
DEPTH = 2

CHUNK = 64
EPS = 1e-6
GMLP_BLOCK = 128
GMLP_GROUPS = 4
GMLP_GROUP_DIM = 128
GMLP_WIDTH = GMLP_GROUPS * GMLP_GROUP_DIM
HG_HEADS = 8
HG_DK = 128
HG_DV = D_MODEL // HG_HEADS
HG_WIDTH = HG_HEADS * HG_DK
HG_VWIDTH = HG_HEADS * HG_DV
N_BRANCH = 2
D_FF = 4 * D_MODEL
IN_SPLITS = (GMLP_WIDTH, GMLP_WIDTH, HG_WIDTH, HG_WIDTH, HG_VWIDTH, HG_VWIDTH, D_MODEL, D_MODEL)
IN_COLS = sum(IN_SPLITS)

kernel_name = "hybrid_gmlp_hgrn2_gated_trunk"


def rmsnorm(x, g):
    xf = x.astype(jnp.float32)
    y = xf * lax.rsqrt(jnp.mean(xf * xf, axis=-1, keepdims=True) + EPS)
    return (y * g.astype(jnp.float32)).astype(x.dtype)


def layernorm(x, g, b):
    xf = x.astype(jnp.float32)
    mu = jnp.mean(xf, axis=-1, keepdims=True)
    xc = xf - mu
    y = xc * lax.rsqrt(jnp.mean(xc * xc, axis=-1, keepdims=True) + EPS)
    return (y * g.astype(jnp.float32) + b.astype(jnp.float32)).astype(x.dtype)


def chunk_causal_mask(n):
    c = jnp.arange(n) // CHUNK
    return c[None, :] <= c[:, None]


def gmlp_branch(zu, zv, ln_g, ln_b, w_s, b_s):
    B, S, _ = zu.shape
    nb = S // GMLP_BLOCK
    u = jax.nn.gelu(zu, approximate=False)
    v = layernorm(jax.nn.gelu(zv, approximate=False), ln_g, ln_b)
    v = v.reshape(B, nb, GMLP_BLOCK, GMLP_GROUPS, GMLP_GROUP_DIM)
    w = jnp.where(chunk_causal_mask(GMLP_BLOCK)[None], w_s, 0).astype(v.dtype)
    mixed = jnp.einsum('gqp,bnpgc->bnqgc', w, v) + b_s.T.astype(v.dtype)[None, None, :, :, None]
    return u * mixed.reshape(B, S, GMLP_WIDTH)


def hgrn2_lower_bounds(lb_param):
    p = jax.nn.softmax(lb_param.astype(jnp.float32), axis=0)
    return jnp.cumsum(p, axis=0) - p[0]


def hgrn2_chunkwise(q, k, v, log_f):
    B, S, H, DK = q.shape
    DV = v.shape[-1]
    nc = S // CHUNK

    def to_chunks(t):
        return t.reshape(B, nc, CHUNK, H, t.shape[-1]).transpose(1, 0, 3, 2, 4)

    tri = jnp.tril(jnp.ones((CHUNK, CHUNK), dtype=bool))[:, :, None]

    def step(state, inp):
        qb, kb, vb, gb = inp
        cum = jnp.cumsum(gb, axis=2)
        o_inter = jnp.einsum('bhtk,bhkv->bhtv', qb * jnp.exp(cum), state)
        rel = cum[:, :, :, None, :] - cum[:, :, None, :, :]
        decay = jnp.exp(jnp.where(tri, rel, -jnp.inf))
        scores = jnp.einsum('bhtk,bhsk,bhtsk->bhts', qb, kb, decay)
        o_intra = jnp.einsum('bhts,bhsv->bhtv', scores, vb)
        last = cum[:, :, -1:, :]
        k_dec = kb * jnp.exp(last - cum)
        state = state * jnp.exp(last[:, :, 0, :])[..., None] + jnp.einsum('bhsk,bhsv->bhkv', k_dec, vb)
        return state, o_inter + o_intra

    state0 = jnp.zeros((B, H, DK, DV), jnp.float32)
    _, out = lax.scan(step, state0, (to_chunks(q), to_chunks(k), to_chunks(v), to_chunks(log_f)))
    return out.transpose(1, 0, 3, 2, 4).reshape(B, S, H, DV)


def hgrn2_branch(zq, zf, zi, zo, lb, layer_idx, norm_g):
    B, S, _ = zq.shape
    dt = zq.dtype
    zf32 = zf.astype(jnp.float32)
    if layer_idx == 0:
        log_f = jax.nn.log_sigmoid(zf32)
        k = jax.nn.sigmoid(-zf32)
    else:
        f = lb[None, None, :] + (1.0 - lb[None, None, :]) * jax.nn.sigmoid(zf32)
        log_f = jnp.log(f)
        k = 1.0 - f
    q = jax.nn.silu(zq.astype(jnp.float32))
    heads = lambda t, d: t.reshape(B, S, HG_HEADS, d)
    o = hgrn2_chunkwise(heads(q, HG_DK), heads(k, HG_DK),
                        heads(zi.astype(jnp.float32), HG_DV), heads(log_f, HG_DK))
    o = rmsnorm(o, norm_g) * jax.nn.silu(heads(zo.astype(jnp.float32), HG_DV))
    return o.reshape(B, S, HG_VWIDTH).astype(dt)


def setup_inputs(seed: int = 0) -> dict:
    key = jax.random.key(seed)
    ks = jax.random.split(key, 16)
    n = jax.random.normal
    f32 = jnp.float32
    return {
        "x": n(ks[0], (BATCH, SEQ, D_MODEL), f32),
        "w_in": n(ks[1], (DEPTH, D_MODEL, IN_COLS), f32) * D_MODEL ** -0.5,
        "gmlp_ln_g": 1.0 + 0.05 * n(ks[2], (DEPTH, GMLP_WIDTH), f32),
        "gmlp_ln_b": 0.02 * n(ks[3], (DEPTH, GMLP_WIDTH), f32),
        "gmlp_ws": n(ks[4], (DEPTH, GMLP_GROUPS, GMLP_BLOCK, GMLP_BLOCK), f32) * GMLP_BLOCK ** -0.5,
        "gmlp_bs": 1.0 + 0.05 * n(ks[5], (DEPTH, GMLP_GROUPS, GMLP_BLOCK), f32),
        "w_up_a": n(ks[6], (DEPTH, GMLP_WIDTH, D_MODEL), f32) * GMLP_WIDTH ** -0.5,
        "hg_lb": 0.5 * n(ks[7], (DEPTH, HG_WIDTH), f32),
        "hg_norm_g": 1.0 + 0.05 * n(ks[8], (DEPTH, HG_DV), f32),
        "w_up_b": n(ks[9], (DEPTH, HG_VWIDTH, D_MODEL), f32) * HG_VWIDTH ** -0.5,
        "w_out": n(ks[10], (DEPTH, D_MODEL, D_MODEL), f32) * D_MODEL ** -0.5,
        "norm_mix": 1.0 + 0.05 * n(ks[11], (DEPTH, D_MODEL), f32),
        "norm_ffn": 1.0 + 0.05 * n(ks[12], (DEPTH, D_MODEL), f32),
        "w_ff1": n(ks[13], (DEPTH, D_MODEL, D_FF), f32) * D_MODEL ** -0.5,
        "w_ff2": n(ks[14], (DEPTH, D_FF, D_MODEL), f32) * (0.5 * D_FF ** -0.5),
        "final_norm": 1.0 + 0.05 * n(ks[15], (D_MODEL,), f32),
    }


def reference(x, w_in, gmlp_ln_g, gmlp_ln_b, gmlp_ws, gmlp_bs, w_up_a, hg_lb, hg_norm_g,
              w_up_b, w_out, norm_mix, norm_ffn, w_ff1, w_ff2, final_norm):
    split_points = [int(s) for s in np.cumsum(IN_SPLITS)[:-1]]
    lower_bounds = hgrn2_lower_bounds(hg_lb)
    for l in range(DEPTH):
        h = rmsnorm(x, norm_mix[l])
        proj = h @ w_in[l]
        zu, zv, zq, zf, zi, zo, g_a, g_b = jnp.split(proj, split_points, axis=-1)
        y_a = gmlp_branch(zu, zv, gmlp_ln_g[l], gmlp_ln_b[l], gmlp_ws[l], gmlp_bs[l]) @ w_up_a[l]
        y_b = hgrn2_branch(zq, zf, zi, zo, lower_bounds[l], l, hg_norm_g[l]) @ w_up_b[l]
        mix = jax.nn.sigmoid(g_a) * y_a + jax.nn.sigmoid(g_b) * y_b
        x = x + mix @ w_out[l]
        h = rmsnorm(x, norm_ffn[l])
        x = x + jnp.square(jax.nn.relu(h @ w_ff1[l])) @ w_ff2[l]
    return rmsnorm(x, final_norm)
```

```cpp
#include <hip/hip_runtime.h>
#include <hip/hip_cooperative_groups.h>
#include <cstdio>
#include <cstdint>
namespace cg = cooperative_groups;
#define MK_MULTI 0
#ifndef DUP_B1
#define DUP_B1 1
#endif
#ifndef DUP_P1
#define DUP_P1 1
#endif

#define LAS __attribute__((address_space(3)))
typedef unsigned short bf16_t;
typedef short bf16x8 __attribute__((ext_vector_type(8)));
typedef float f32x4 __attribute__((ext_vector_type(4)));
typedef float f32x2 __attribute__((ext_vector_type(2)));
typedef unsigned u32x4 __attribute__((ext_vector_type(4)));
typedef unsigned u32x2 __attribute__((ext_vector_type(2)));

constexpr int DM = 1024, BATCH = 8, SEQ = 4096, MTOT = BATCH * SEQ;
constexpr int INC = 7168, DFF = 4096, GW = 512;
constexpr float EPS = 1e-6f;

__device__ __forceinline__ float bf2f(unsigned v) { return __uint_as_float(v << 16); }
typedef __bf16 bf16x2_t __attribute__((ext_vector_type(2)));
__device__ __forceinline__ unsigned cvt_pk_bf16(float lo, float hi) { f32x2 v = {lo, hi}; bf16x2_t b = __builtin_convertvector(v, bf16x2_t); return __builtin_bit_cast(unsigned, b); }
__device__ __forceinline__ float fast_rcp(float x) { return __builtin_amdgcn_rcpf(x); }
__device__ __forceinline__ float sigmoidf_(float x) { return fast_rcp(1.0f + __expf(-x)); }
__device__ __forceinline__ float siluf_(float x) { return x * sigmoidf_(x); }
__device__ __forceinline__ f32x2 gelu_pk(f32x2 v) {
    const f32x2 av = __builtin_elementwise_abs(v), d = av * 0.2316418882f + 1.0f;
    f32x2 t; t.x = __builtin_amdgcn_rcpf(d.x); t.y = __builtin_amdgcn_rcpf(d.y);
    f32x2 q = t * 0.5307027145f + (-0.7265760135f); q = q * t + 0.7107068705f; q = q * t + (-0.142248368f); q = q * t + 0.127414796f; q = q * t;
    const f32x2 s = (v * v) * (-0.72134752044f);
    f32x2 e; e.x = __builtin_amdgcn_exp2f(s.x); e.y = __builtin_amdgcn_exp2f(s.y);
    const f32x2 m = v * (q * e), r = v - m;
    f32x2 o; o.x = v.x < 0.f ? m.x : r.x; o.y = v.y < 0.f ? m.y : r.y; return o;
}
__device__ __forceinline__ float wave_sum(float v) {
#pragma unroll
    for (int o = 1; o < 64; o <<= 1) v += __shfl_xor(v, o);
    return v;
}

namespace pg8 {
constexpr int BM = 256, BK = 64, HALF = 128, HTB = HALF * BK * 2, STAGE_BYTES = 8 * HTB, NXCD = 8, WGM = 8;
__host__ __device__ __forceinline__ int lds_byte(int r, int c) { const int st = (r >> 4) * 2 + (c >> 5), rr = r & 15, cc = c & 31, ob = rr * 64 + cc * 2; return st * 1024 + (ob ^ (((ob >> 9) & 1) << 5)); }
__host__ __device__ __forceinline__ void stage_rc(int b, int& R, int& C) { const int st = b / 1024, sb = b % 1024, swz = sb ^ (((sb >> 9) & 1) << 5); R = (st >> 1) * 16 + swz / 64; C = (st & 1) * 32 + (swz % 64) / 2; }
__host__ __device__ __forceinline__ int perm32(int rho) { const int n = rho >> 4, i = rho & 15; return 8 * (i >> 2) + 4 * n + (i & 3); }
struct Unit { int pm, pn; };
struct Gemm { const bf16_t* A; const bf16_t* Bt; int M, N, K; };
struct StaticOrder {
    int nM, nN, nwg, G, c;
    __device__ void init(int M, int N, int G_, int c_) { nM = M / BM; nN = N / BM; nwg = nM * nN; G = G_; c = c_; }
    __device__ bool next(int i, Unit& u) const {
        const long L = (long)i * G + c; if (L >= nwg) return false;
        int wgid = (int)L; { const int q = nwg / NXCD, r = nwg % NXCD, xcd = wgid % NXCD, off = wgid / NXCD; wgid = (xcd < r ? xcd * (q + 1) : r * (q + 1) + (xcd - r) * q) + off; }
        const int nig = WGM * nN, gid = wgid / nig, fm = gid * WGM, gsz = (nM - fm) < WGM ? (nM - fm) : WGM;
        u.pm = fm + ((wgid % nig) % gsz); u.pn = (wgid % nig) / gsz; return true;
    }
};
template <class Epi>
__device__ __forceinline__ void gemm_phase(LAS unsigned char* lds, const Gemm g, const StaticOrder& S, const Epi& E, const int tid) {
    const int wid = __builtin_amdgcn_readfirstlane(tid >> 6), lane = tid & 63, wr = wid >> 2, wc = wid & 3, fr = lane & 15, fq = lane >> 4;
    const int K = g.K, nt = K / BK;
    unsigned voffA[2], voffB[2];
#pragma unroll
    for (int i = 0; i < 2; ++i) { int R, C; stage_rc(tid * 16 + i * 8192, R, C); const int Rb = (R & ~31) + perm32(R & 31);
        voffA[i] = (unsigned)(R * K + C) * 2u; voffB[i] = (unsigned)(Rb * K + C) * 2u; }
    const size_t kstep = (size_t)(BK * 2);
    const size_t hstep = (size_t)HALF * K * 2;
    const size_t tstep = 2 * hstep;
    const unsigned ldsw = (unsigned)wid * 1024u;
    const int aoff = lds_byte(wr * 64 + fr, fq * 8), boff = lds_byte(wc * 32 + fr, fq * 8);
#define PG8_SA(b, h) (((b) * 2 + (h)) * HTB)
#define PG8_SB(b, h) ((4 + (b) * 2 + (h)) * HTB)
#define PG8_STAGE(bufoff, gbase, voff) do { _Pragma("unroll") for (int _i = 0; _i < 2; ++_i) \
        __builtin_amdgcn_global_load_lds((const unsigned*)((const char*)(gbase) + (voff)[_i]), (LAS unsigned*)(lds + (bufoff) + ldsw + _i * 8192), 16, 0, 0); } while (0)
#define PG8_LDA(dst, b, h) do { _Pragma("unroll") for (int m = 0; m < 4; ++m) _Pragma("unroll") for (int k = 0; k < 2; ++k) dst[m][k] = *(const LAS bf16x8*)(lds + PG8_SA(b, h) + aoff + m * 2048 + k * 1024); } while (0)
#define PG8_LDB(dst, b, h) do { _Pragma("unroll") for (int n = 0; n < 2; ++n) _Pragma("unroll") for (int k = 0; k < 2; ++k) dst[n][k] = *(const LAS bf16x8*)(lds + PG8_SB(b, h) + boff + n * 2048 + k * 1024); } while (0)
#define PG8_MMA(ai, bj, At, Bt) do { __builtin_amdgcn_s_setprio(1); _Pragma("unroll") for (int m = 0; m < 4; ++m) _Pragma("unroll") for (int n = 0; n < 2; ++n) _Pragma("unroll") for (int k = 0; k < 2; ++k) \
        acc[ai][bj][m][n] = __builtin_amdgcn_mfma_f32_16x16x32_bf16(Bt[n][k], At[m][k], acc[ai][bj][m][n], 0, 0, 0); __builtin_amdgcn_s_setprio(0); } while (0)
#define PG8_WAIT_V(n) asm volatile("s_waitcnt vmcnt(" #n ")" ::: "memory")
#define PG8_WAIT_L(n) asm volatile("s_waitcnt lgkmcnt(" #n ")" ::: "memory")
#define PG8_BAR __builtin_amdgcn_s_barrier()
#define PG8_SCHED __builtin_amdgcn_sched_barrier(0)
    Unit cur, nxt; int ui = 0;
    if (!S.next(0, cur)) return;
    f32x4 acc[2][2][4][2];
    E.init(acc, cur, wr, wc, fr, fq);
    bf16x8 At[4][2], B0[2][2], B1[2][2];
    const char* cA = (const char*)g.A + (size_t)cur.pm * tstep; const char* cB = (const char*)g.Bt + (size_t)cur.pn * tstep;
    PG8_STAGE(PG8_SB(0, 0), cB, voffB); PG8_STAGE(PG8_SB(0, 1), cB + hstep, voffB); PG8_STAGE(PG8_SA(0, 0), cA, voffA); PG8_STAGE(PG8_SA(0, 1), cA + hstep, voffA);
    if (wr == 1) PG8_BAR;
    PG8_WAIT_V(2); PG8_BAR;
    PG8_STAGE(PG8_SB(1, 0), cB + kstep, voffB); PG8_STAGE(PG8_SA(1, 0), cA + kstep, voffA); PG8_STAGE(PG8_SB(1, 1), cB + hstep + kstep, voffB);
    PG8_WAIT_V(6); PG8_BAR;
    for (;;) {
        const bool has_next = S.next(ui + 1, nxt);
        const char* nA = has_next ? (const char*)g.A + (size_t)nxt.pm * tstep : cA; const char* nB = has_next ? (const char*)g.Bt + (size_t)nxt.pn * tstep : cB;
        for (int t = 0; t < nt; t += 2) {
            const bool last = (t == nt - 2);
            const char* a1 = cA + (size_t)(t + 1) * kstep;
            const char* a2 = last ? nA : cA + (size_t)(t + 2) * kstep; const char* b2 = last ? nB : cB + (size_t)(t + 2) * kstep;
            const char* a3 = a2 + kstep; const char* b3 = b2 + kstep;
            PG8_LDB(B0, 0, 0); PG8_LDB(B1, 0, 1); PG8_SCHED; PG8_LDA(At, 0, 0); PG8_STAGE(PG8_SA(1, 1), a1 + hstep, voffA);
            PG8_WAIT_V(8); PG8_WAIT_L(0); PG8_BAR; PG8_MMA(0, 0, At, B0); PG8_MMA(0, 1, At, B1); PG8_BAR; PG8_SCHED;
            PG8_LDA(At, 0, 1); PG8_STAGE(PG8_SB(0, 0), b2, voffB); PG8_STAGE(PG8_SB(0, 1), b2 + hstep, voffB); PG8_STAGE(PG8_SA(0, 0), a2, voffA);
            PG8_WAIT_V(8); PG8_WAIT_L(0); PG8_BAR; PG8_MMA(1, 0, At, B0); PG8_MMA(1, 1, At, B1); PG8_BAR; PG8_SCHED;
            PG8_LDB(B0, 1, 0); PG8_LDB(B1, 1, 1); PG8_SCHED; PG8_LDA(At, 1, 0); PG8_STAGE(PG8_SA(0, 1), a2 + hstep, voffA);
            PG8_WAIT_V(8); PG8_WAIT_L(0); PG8_BAR; PG8_MMA(0, 0, At, B0); PG8_MMA(0, 1, At, B1); PG8_BAR; PG8_SCHED;
            PG8_LDA(At, 1, 1); PG8_STAGE(PG8_SB(1, 0), b3, voffB); PG8_STAGE(PG8_SB(1, 1), b3 + hstep, voffB); PG8_STAGE(PG8_SA(1, 0), a3, voffA);
            PG8_WAIT_V(8); PG8_WAIT_L(0); PG8_BAR; PG8_MMA(1, 0, At, B0); PG8_MMA(1, 1, At, B1); PG8_BAR; PG8_SCHED;
        }
        if (wr == 0) PG8_BAR;
        E(acc, cur, wr, wc, fr, fq);
        if (!has_next) break;
        E.init(acc, nxt, wr, wc, fr, fq);
        cur = nxt; cA = nA; cB = nB; ++ui;
        if (wr == 1) PG8_BAR;
    }
    PG8_WAIT_V(0);
    PG8_BAR;
#undef PG8_SA
#undef PG8_SB
#undef PG8_STAGE
#undef PG8_LDA
#undef PG8_LDB
#undef PG8_MMA
#undef PG8_WAIT_V
#undef PG8_WAIT_L
#undef PG8_BAR
#undef PG8_SCHED
}
}
using pg8::Unit;

constexpr size_t WS_LBV = 0;
constexpr size_t WS_W = 1u << 20;
constexpr size_t WL_IN = 0, WL_A = WL_IN + (size_t)INC * DM * 2, WL_B = WL_A + (size_t)DM * GW * 2, WL_O = WL_B + (size_t)DM * DM * 2,
                 WL_1 = WL_O + (size_t)DM * DM * 2, WL_2 = WL_1 + (size_t)DFF * DM * 2, WL_SIZE = WL_2 + (size_t)DM * DFF * 2;
constexpr size_t WS_XB = WS_W + WL_SIZE;
constexpr size_t WS_SSP = WS_XB + (size_t)MTOT * DM * 2;
constexpr size_t WS_P = WS_SSP + (size_t)MTOT * 16 * 4;
constexpr size_t P_U = 0, P_V = P_U + (size_t)MTOT * GW * 2, P_Q = P_V + (size_t)MTOT * GW * 2, P_F = P_Q + (size_t)MTOT * DM * 2, P_I = P_F + (size_t)MTOT * DM * 2,
                 P_ZO = P_I + (size_t)MTOT * DM * 2, P_GA = P_ZO + (size_t)MTOT * DM * 2, P_GB = P_GA + (size_t)MTOT * DM  , P_VST = P_GB + (size_t)MTOT * DM,
                 P_D = P_VST + (size_t)MTOT * 8 * 8, P_SEGB = P_D + (size_t)4096 * 128 * 4, P_SEGA = P_SEGB + (size_t)256 * 16384 * 4, P_END = P_SEGA + (size_t)256 * 128 * 4;
constexpr size_t WS_H1 = WS_P;
constexpr size_t WS_END = WS_P + (P_END > (size_t)MTOT * DFF * 2 ? P_END : (size_t)MTOT * DFF * 2);
static_assert(WS_END <= 536870912ull, "workspace map exceeds 512 MiB");

__device__ __forceinline__ float rstd4(const f32x4 p) { return rsqrtf(((p[0] + p[1]) + (p[2] + p[3])) * (1.0f / DM) + EPS); }

struct EpiInProj {
    const float* ssp; unsigned char* P; f32x2* vst;
    __device__ __forceinline__ void init(f32x4 (&acc)[2][2][4][2], const Unit&, int, int, int, int) const {
#pragma unroll
        for (int a_ = 0; a_ < 2; ++a_)
#pragma unroll
            for (int b_ = 0; b_ < 2; ++b_)
#pragma unroll
                for (int m_ = 0; m_ < 4; ++m_)
#pragma unroll
                    for (int n_ = 0; n_ < 2; ++n_) acc[a_][b_][m_][n_] = (f32x4){0.f, 0.f, 0.f, 0.f};
    }
    __device__ __forceinline__ void operator()(const f32x4 (&acc)[2][2][4][2], const Unit& u, int wr, int wc, int fr, int fq) const {
        const int pn = u.pn; size_t boff; int ldc, colt, act;
        if (pn < 2) { boff = P_U; ldc = GW; colt = pn * 256; act = 1; }
        else if (pn < 4) { boff = P_V; ldc = GW; colt = (pn - 2) * 256; act = 2; }
        else if (pn < 8) { boff = P_Q; ldc = DM; colt = (pn - 4) * 256; act = 3; }
        else if (pn < 12) { boff = P_F; ldc = DM; colt = (pn - 8) * 256; act = 0; }
        else if (pn < 16) { boff = P_I; ldc = DM; colt = (pn - 12) * 256; act = 0; }
        else if (pn < 20) { boff = P_ZO; ldc = DM; colt = (pn - 16) * 256; act = 3; }
        else if (pn < 24) { boff = P_GA; ldc = DM / 2; colt = (pn - 20) * 256; act = 4; }
        else { boff = P_GB; ldc = DM / 2; colt = (pn - 24) * 256; act = 4; }
        bf16_t* base = (bf16_t*)(P + boff);
        const int col0 = colt + wc * 32 + 8 * fq;
        f32x4 pr[2][4];
#pragma unroll
        for (int ai = 0; ai < 2; ++ai)
#pragma unroll
            for (int m = 0; m < 4; ++m) pr[ai][m] = *(const f32x4*)(ssp + (size_t)(u.pm * 256 + ai * 128 + wr * 64 + m * 16 + fr) * 4);
#pragma unroll
        for (int ai = 0; ai < 2; ++ai)
#pragma unroll
            for (int m = 0; m < 4; ++m) {
                const int row = u.pm * 256 + ai * 128 + wr * 64 + m * 16 + fr;
                const float rs = rstd4(pr[ai][m]);
                bf16_t* rowp = base + (size_t)row * ldc + col0;
                float s1 = 0.f, s2 = 0.f;
#pragma unroll
                for (int bj = 0; bj < 2; ++bj) {
                    f32x4 v0 = acc[ai][bj][m][0] * rs, v1 = acc[ai][bj][m][1] * rs;
                    if (act == 1 || act == 2) {
                        f32x2 a = gelu_pk((f32x2){v0[0], v0[1]}), b = gelu_pk((f32x2){v0[2], v0[3]}), c = gelu_pk((f32x2){v1[0], v1[1]}), d = gelu_pk((f32x2){v1[2], v1[3]});
                        v0 = (f32x4){a.x, a.y, b.x, b.y}; v1 = (f32x4){c.x, c.y, d.x, d.y};
                        if (act == 2) {
                            s1 += ((v0[0] + v0[1]) + (v0[2] + v0[3])) + ((v1[0] + v1[1]) + (v1[2] + v1[3]));
                            s2 += ((v0[0] * v0[0] + v0[1] * v0[1]) + (v0[2] * v0[2] + v0[3] * v0[3])) + ((v1[0] * v1[0] + v1[1] * v1[1]) + (v1[2] * v1[2] + v1[3] * v1[3]));
                        }
                    } else if (act == 3) {
#pragma unroll
                        for (int e = 0; e < 4; ++e) { v0[e] = siluf_(v0[e]); v1[e] = siluf_(v1[e]); }
                    } else if (act == 4) {
                        unsigned q0 = 0u, q1 = 0u;
#pragma unroll
                        for (int e = 0; e < 4; ++e) { q0 |= (unsigned)(sigmoidf_(v0[e]) * 255.0f + 0.5f) << (8 * e); q1 |= (unsigned)(sigmoidf_(v1[e]) * 255.0f + 0.5f) << (8 * e); }
                        *(u32x2*)((unsigned char*)base + (size_t)row * DM + col0 + bj * 128) = (u32x2){q0, q1};
                        continue;
                    }
                    u32x4 w; w.x = cvt_pk_bf16(v0[0], v0[1]); w.y = cvt_pk_bf16(v0[2], v0[3]); w.z = cvt_pk_bf16(v1[0], v1[1]); w.w = cvt_pk_bf16(v1[2], v1[3]);
                    *(u32x4*)(rowp + bj * 128) = w;
                }
                if (act == 2) {
                    s1 += __shfl_xor(s1, 16); s1 += __shfl_xor(s1, 32); s2 += __shfl_xor(s2, 16); s2 += __shfl_xor(s2, 32);
                    if (fq == 0) vst[(size_t)row * 8 + (pn - 2) * 4 + wc] = (f32x2){s1, s2};
                }
            }
    }
};
struct EpiMix {
    const unsigned char* G; bf16_t* MIX; int first;
    __device__ __forceinline__ void init(f32x4 (&acc)[2][2][4][2], const Unit&, int, int, int, int) const {
#pragma unroll
        for (int a_ = 0; a_ < 2; ++a_)
#pragma unroll
            for (int b_ = 0; b_ < 2; ++b_)
#pragma unroll
                for (int m_ = 0; m_ < 4; ++m_)
#pragma unroll
                    for (int n_ = 0; n_ < 2; ++n_) acc[a_][b_][m_][n_] = (f32x4){0.f, 0.f, 0.f, 0.f};
    }
    __device__ __forceinline__ void operator()(const f32x4 (&acc)[2][2][4][2], const Unit& u, int wr, int wc, int fr, int fq) const {
        const int col0 = u.pn * 256 + wc * 32 + 8 * fq;
        u32x2 gq[2][4][2];
#pragma unroll
        for (int ai = 0; ai < 2; ++ai)
#pragma unroll
            for (int m = 0; m < 4; ++m) {
                const size_t off = (size_t)(u.pm * 256 + ai * 128 + wr * 64 + m * 16 + fr) * DM + col0;
#pragma unroll
                for (int bj = 0; bj < 2; ++bj) gq[ai][m][bj] = *(const u32x2*)(G + off + bj * 128);
            }
        u32x4 mq[1][4][2];
#pragma unroll
        for (int m = 0; m < 4; ++m) {
            const size_t off = (size_t)(u.pm * 256 + wr * 64 + m * 16 + fr) * DM + col0;
#pragma unroll
            for (int bj = 0; bj < 2; ++bj) mq[0][m][bj] = first ? (u32x4){0u, 0u, 0u, 0u} : *(const u32x4*)(MIX + off + bj * 128);
        }
#pragma unroll
        for (int ai = 0; ai < 2; ++ai) {
            if (ai == 1) {
#pragma unroll
                for (int m = 0; m < 4; ++m) {
                    const size_t off = (size_t)(u.pm * 256 + 128 + wr * 64 + m * 16 + fr) * DM + col0;
#pragma unroll
                    for (int bj = 0; bj < 2; ++bj) mq[0][m][bj] = first ? (u32x4){0u, 0u, 0u, 0u} : *(const u32x4*)(MIX + off + bj * 128);
                }
            }
#pragma unroll
            for (int m = 0; m < 4; ++m) {
                const size_t off = (size_t)(u.pm * 256 + ai * 128 + wr * 64 + m * 16 + fr) * DM + col0;
#pragma unroll
                for (int bj = 0; bj < 2; ++bj) {
                    const u32x2 g2 = gq[ai][m][bj]; const u32x4 m4 = mq[0][m][bj];
                    constexpr float IG = 1.0f / 255.0f;
                    f32x4 v0 = acc[ai][bj][m][0], v1 = acc[ai][bj][m][1];
                    v0[0] = v0[0] * ((float)(g2.x & 255u) * IG) + bf2f(m4.x & 0xffffu); v0[1] = v0[1] * ((float)((g2.x >> 8) & 255u) * IG) + bf2f(m4.x >> 16);
                    v0[2] = v0[2] * ((float)((g2.x >> 16) & 255u) * IG) + bf2f(m4.y & 0xffffu); v0[3] = v0[3] * ((float)(g2.x >> 24) * IG) + bf2f(m4.y >> 16);
                    v1[0] = v1[0] * ((float)(g2.y & 255u) * IG) + bf2f(m4.z & 0xffffu); v1[1] = v1[1] * ((float)((g2.y >> 8) & 255u) * IG) + bf2f(m4.z >> 16);
                    v1[2] = v1[2] * ((float)((g2.y >> 16) & 255u) * IG) + bf2f(m4.w & 0xffffu); v1[3] = v1[3] * ((float)(g2.y >> 24) * IG) + bf2f(m4.w >> 16);
                    u32x4 w; w.x = cvt_pk_bf16(v0[0], v0[1]); w.y = cvt_pk_bf16(v0[2], v0[3]); w.z = cvt_pk_bf16(v1[0], v1[1]); w.w = cvt_pk_bf16(v1[2], v1[3]);
                    *(u32x4*)(MIX + off + bj * 128) = w;
                }
            }
        }
    }
};
struct EpiResid {
    bf16_t* XB; float* ssp; LAS unsigned char* red;
    __device__ __forceinline__ void init(f32x4 (&acc)[2][2][4][2], const Unit& u, int wr, int wc, int fr, int fq) const {
        const int col0 = u.pn * 256 + wc * 32 + 8 * fq;
#pragma unroll
        for (int ai = 0; ai < 2; ++ai)
#pragma unroll
            for (int m = 0; m < 4; ++m) {
                const size_t off = (size_t)(u.pm * 256 + ai * 128 + wr * 64 + m * 16 + fr) * DM + col0;
#pragma unroll
                for (int bj = 0; bj < 2; ++bj) {
                    const u32x4 q = *(const u32x4*)(XB + off + bj * 128);
                    acc[ai][bj][m][0] = (f32x4){bf2f(q.x & 0xffffu), bf2f(q.x >> 16), bf2f(q.y & 0xffffu), bf2f(q.y >> 16)};
                    acc[ai][bj][m][1] = (f32x4){bf2f(q.z & 0xffffu), bf2f(q.z >> 16), bf2f(q.w & 0xffffu), bf2f(q.w >> 16)};
                }
            }
    }
    __device__ __forceinline__ void operator()(const f32x4 (&acc)[2][2][4][2], const Unit& u, int wr, int wc, int fr, int fq) const {
        const int col0 = u.pn * 256 + wc * 32 + 8 * fq;
#pragma unroll
        for (int ai = 0; ai < 2; ++ai)
#pragma unroll
            for (int m = 0; m < 4; ++m) {
                const int rl = ai * 128 + wr * 64 + m * 16 + fr;
                const size_t off = (size_t)(u.pm * 256 + rl) * DM + col0;
                float ss = 0.f;
#pragma unroll
                for (int bj = 0; bj < 2; ++bj) {
                    const f32x4 v0 = acc[ai][bj][m][0], v1 = acc[ai][bj][m][1];
                    ss += ((v0[0] * v0[0] + v0[1] * v0[1]) + (v0[2] * v0[2] + v0[3] * v0[3])) + ((v1[0] * v1[0] + v1[1] * v1[1]) + (v1[2] * v1[2] + v1[3] * v1[3]));
                    u32x4 w; w.x = cvt_pk_bf16(v0[0], v0[1]); w.y = cvt_pk_bf16(v0[2], v0[3]); w.z = cvt_pk_bf16(v1[0], v1[1]); w.w = cvt_pk_bf16(v1[2], v1[3]);
                    *(u32x4*)(XB + off + bj * 128) = w;
                }
                ss += __shfl_xor(ss, 16); ss += __shfl_xor(ss, 32);
                if (fq == 0) *(LAS float*)(red + (rl * 4 + wc) * 4) = ss;
            }
        asm volatile("s_waitcnt lgkmcnt(0)" ::: "memory"); __builtin_amdgcn_s_barrier(); asm volatile("" ::: "memory");
        const int t = (wr * 4 + wc) * 64 + fq * 16 + fr;
        if (t < 256) { const f32x4 p = *(const LAS f32x4*)(red + t * 16); ssp[(size_t)(u.pm * 256 + t) * 4 + u.pn] = (p[0] + p[1]) + (p[2] + p[3]); }
    }
};
struct EpiFF1 {
    const float* ssp; bf16_t* H;
    __device__ __forceinline__ void init(f32x4 (&acc)[2][2][4][2], const Unit&, int, int, int, int) const {
#pragma unroll
        for (int a_ = 0; a_ < 2; ++a_)
#pragma unroll
            for (int b_ = 0; b_ < 2; ++b_)
#pragma unroll
                for (int m_ = 0; m_ < 4; ++m_)
#pragma unroll
                    for (int n_ = 0; n_ < 2; ++n_) acc[a_][b_][m_][n_] = (f32x4){0.f, 0.f, 0.f, 0.f};
    }
    __device__ __forceinline__ void operator()(const f32x4 (&acc)[2][2][4][2], const Unit& u, int wr, int wc, int fr, int fq) const {
        const int col0 = u.pn * 256 + wc * 32 + 8 * fq;
        f32x4 pr[2][4];
#pragma unroll
        for (int ai = 0; ai < 2; ++ai)
#pragma unroll
            for (int m = 0; m < 4; ++m) pr[ai][m] = *(const f32x4*)(ssp + (size_t)(u.pm * 256 + ai * 128 + wr * 64 + m * 16 + fr) * 4);
#pragma unroll
        for (int ai = 0; ai < 2; ++ai)
#pragma unroll
            for (int m = 0; m < 4; ++m) {
                const int row = u.pm * 256 + ai * 128 + wr * 64 + m * 16 + fr;
                const float rs = rstd4(pr[ai][m]);
                bf16_t* rowp = H + (size_t)row * DFF + col0;
#pragma unroll
                for (int bj = 0; bj < 2; ++bj) {
                    f32x4 v0 = acc[ai][bj][m][0], v1 = acc[ai][bj][m][1];
#pragma unroll
                    for (int e = 0; e < 4; ++e) { const float a = fmaxf(v0[e], 0.f), b = fmaxf(v1[e], 0.f); v0[e] = a * a; v1[e] = b * b; }
                    v0 = v0 * (rs * rs); v1 = v1 * (rs * rs);
                    u32x4 w; w.x = cvt_pk_bf16(v0[0], v0[1]); w.y = cvt_pk_bf16(v0[2], v0[3]); w.z = cvt_pk_bf16(v1[0], v1[1]); w.w = cvt_pk_bf16(v1[2], v1[3]);
                    *(u32x4*)(rowp + bj * 128) = w;
                }
            }
    }
};

constexpr int LDS_BYTES = 147456;

struct Args { const float* in[16]; float* out; unsigned char* ws; int lo, hi; };

struct P0Item { const float* W; bf16_t* WT; const float* gsc; int K, N, k0, n0; };
__device__ __forceinline__ P0Item p0_decode(const __attribute__((address_space(4))) Args* kp, int it, int l) {
    constexpr int T_IN = 448, T_A = 32, T_B = 64, T_O = 64, T_1 = 256, T_2 = 256, T_L = T_IN + T_A + T_B + T_O + T_1 + T_2;
    int r = it; unsigned char* wl = kp->ws + WS_W;
    P0Item p;
    if (r < T_IN) { p.W = kp->in[1] + (size_t)l * DM * INC; p.K = DM; p.N = INC; p.WT = (bf16_t*)(wl + WL_IN); p.gsc = kp->in[11] + l * DM; }
    else if ((r -= T_IN) < T_A) { p.W = kp->in[6] + (size_t)l * GW * DM; p.K = GW; p.N = DM; p.WT = (bf16_t*)(wl + WL_A); p.gsc = nullptr; }
    else if ((r -= T_A) < T_B) { p.W = kp->in[9] + (size_t)l * DM * DM; p.K = DM; p.N = DM; p.WT = (bf16_t*)(wl + WL_B); p.gsc = nullptr; }
    else if ((r -= T_B) < T_O) { p.W = kp->in[10] + (size_t)l * DM * DM; p.K = DM; p.N = DM; p.WT = (bf16_t*)(wl + WL_O); p.gsc = nullptr; }
    else if ((r -= T_O) < T_1) { p.W = kp->in[13] + (size_t)l * DM * DFF; p.K = DM; p.N = DFF; p.WT = (bf16_t*)(wl + WL_1); p.gsc = kp->in[12] + l * DM; }
    else { r -= T_1; p.W = kp->in[14] + (size_t)l * DFF * DM; p.K = DFF; p.N = DM; p.WT = (bf16_t*)(wl + WL_2); p.gsc = nullptr; }
    const int nblk = p.N / 256; p.k0 = 64 * (r / nblk); p.n0 = 256 * (r % nblk);
    return p;
}
constexpr int P0_NITEMS = 448 + 32 + 64 + 64 + 256 + 256;
__device__ __forceinline__ void p0_load(const P0Item& p, f32x4 (&v)[8], int wid, int lane) {
#pragma unroll
    for (int i = 0; i < 8; ++i) {
        const int kk = p.k0 + wid * 8 + i;
        f32x4 x = __builtin_nontemporal_load((const f32x4*)(p.W + (size_t)kk * p.N + p.n0 + lane * 4));
        if (p.gsc) x = x * p.gsc[kk];
        v[i] = x;
    }
}


__device__ __forceinline__ void p0_transpose_item(const float* W, int K, int N, bf16_t* WT, const float* gsc, LAS float* scr, int item, int lane) {
    const int nblk = N / 32, kb = item / nblk, nb = item % nblk, k0 = 64 * kb, n0 = 32 * nb;
#pragma unroll
    for (int i = 0; i < 32; ++i) { const int kk = 2 * i + (lane >> 5); float w = W[(size_t)(k0 + kk) * N + n0 + (lane & 31)]; if (gsc) w *= gsc[k0 + kk]; scr[kk * 33 + (lane & 31)] = w; }
    asm volatile("s_waitcnt lgkmcnt(0)" ::: "memory");
    const int c = lane & 7;
#pragma unroll
    for (int j = 0; j < 4; ++j) { const int n = (lane >> 3) + 8 * j; const LAS float* s = scr + (8 * c) * 33 + n;
        u32x4 o; o.x = cvt_pk_bf16(s[0 * 33], s[1 * 33]); o.y = cvt_pk_bf16(s[2 * 33], s[3 * 33]); o.z = cvt_pk_bf16(s[4 * 33], s[5 * 33]); o.w = cvt_pk_bf16(s[6 * 33], s[7 * 33]);
        *(u32x4*)(WT + (size_t)(n0 + n) * K + k0 + 8 * c) = o; }
    asm volatile("s_waitcnt lgkmcnt(0)" ::: "memory");
}


__device__ __forceinline__ void gmlp_unit(LAS unsigned char* L, bf16_t* U, const bf16_t* V, const f32x2* vst, const float* Wg, const float* bsg,
                                          const float* lng, const float* lnb, int R0, int g, int tid) {
    constexpr int VT = 0, WSo = 34816, MU = 69632, RSo = MU + 512;
    const int wid = tid >> 6, lane = tid & 63, fr = lane & 15, fq = lane >> 4;
    constexpr int VZg = 73728;
    const float gc = lng[g * 128 + (tid & 127)], bc = lnb[g * 128 + (tid & 127)], bsv = bsg[16 * wid + fr];
    {
        const int wu = __builtin_amdgcn_readfirstlane(tid >> 6);
#pragma unroll
        for (int i = 0; i < 4; ++i) {
            const int p = wu * 64 + i * 512 + lane, row = p >> 4, c8 = p & 15;
            __builtin_amdgcn_global_load_lds((const unsigned*)(V + (size_t)(R0 + row) * GW + g * 128 + c8 * 8), (LAS unsigned*)(L + VZg + (wu * 64 + i * 512) * 16), 16, 0, 0);
        }
    }
    if (tid < 128) {
        const f32x4* p = (const f32x4*)(vst + (size_t)(R0 + tid) * 8);
        const f32x4 a = p[0], b = p[1], c = p[2], d = p[3];
        const float s1 = (a[0] + a[2]) + (b[0] + b[2]) + (c[0] + c[2]) + (d[0] + d[2]);
        const float s2 = (a[1] + a[3]) + (b[1] + b[3]) + (c[1] + c[3]) + (d[1] + d[3]);
        const float mean = s1 * (1.0f / GW), var = fmaxf(s2 * (1.0f / GW) - mean * mean, 0.f);
        *(LAS float*)(L + MU + tid * 4) = mean; *(LAS float*)(L + RSo + tid * 4) = rsqrtf(var + EPS);
    }
#pragma unroll
    for (int i = 0; i < 8; ++i) {
        const int p = tid + i * 512, q = p >> 5, p4 = (p & 31) * 4;
        f32x4 w = *(const f32x4*)(Wg + q * 128 + p4);
        if (q < 64 && p4 >= 64) w = (f32x4){0.f, 0.f, 0.f, 0.f};
        u32x2 o; o.x = cvt_pk_bf16(w[0], w[1]); o.y = cvt_pk_bf16(w[2], w[3]);
        *(LAS u32x2*)(L + WSo + q * 272 + p4 * 2) = o;
    }
    asm volatile("s_waitcnt vmcnt(0)" ::: "memory");
    __syncthreads();
    u32x2 uq8[8];
#pragma unroll
    for (int ct = 0; ct < 8; ++ct) uq8[ct] = *(const u32x2*)(U + (size_t)(R0 + 16 * wid + fr) * GW + g * 128 + 16 * ct + 4 * fq);
    {
        const int c = tid & 127, pq = tid >> 7;
        unsigned short raw[32];
#pragma unroll
        for (int j = 0; j < 32; ++j) raw[j] = *(const LAS unsigned short*)(L + VZg + (32 * pq + j) * 256 + c * 2);
        unsigned pk[16];
#pragma unroll
        for (int j = 0; j < 32; j += 2) {
            const int p0 = 32 * pq + j;
            const float m0 = *(LAS float*)(L + MU + p0 * 4), r0 = *(LAS float*)(L + RSo + p0 * 4), m1 = *(LAS float*)(L + MU + p0 * 4 + 4), r1 = *(LAS float*)(L + RSo + p0 * 4 + 4);
            const float y0 = (bf2f(raw[j]) - m0) * r0 * gc + bc, y1 = (bf2f(raw[j + 1]) - m1) * r1 * gc + bc;
            pk[j >> 1] = cvt_pk_bf16(y0, y1);
        }
#pragma unroll
        for (int j = 0; j < 4; ++j) *(LAS u32x4*)(L + VT + c * 272 + pq * 64 + j * 16) = (u32x4){pk[4 * j], pk[4 * j + 1], pk[4 * j + 2], pk[4 * j + 3]};
    }
    __syncthreads();
    {
        bf16x8 yb[4];
#pragma unroll
        for (int ks = 0; ks < 4; ++ks) yb[ks] = *(const LAS bf16x8*)(L + WSo + (16 * wid + fr) * 272 + (ks * 32 + fq * 8) * 2);
        const int q = 16 * wid + fr;
#pragma unroll
        for (int ct = 0; ct < 8; ++ct) {
            f32x4 acc = (f32x4){0.f, 0.f, 0.f, 0.f};
#pragma unroll
            for (int ks = 0; ks < 4; ++ks) {
                const bf16x8 xa = *(const LAS bf16x8*)(L + VT + (16 * ct + fr) * 272 + (ks * 32 + fq * 8) * 2);
                acc = __builtin_amdgcn_mfma_f32_16x16x32_bf16(xa, yb[ks], acc, 0, 0, 0);
            }
            bf16_t* up = U + (size_t)(R0 + q) * GW + g * 128 + 16 * ct + 4 * fq;
            const u32x2 uq = uq8[ct];
            u32x2 o;
            o.x = cvt_pk_bf16(bf2f(uq.x & 0xffffu) * (acc[0] + bsv), bf2f(uq.x >> 16) * (acc[1] + bsv));
            o.y = cvt_pk_bf16(bf2f(uq.y & 0xffffu) * (acc[2] + bsv), bf2f(uq.y >> 16) * (acc[3] + bsv));
            *(u32x2*)up = o;
        }
    }
    __syncthreads();
}

constexpr int B1_FZ = 40960, B1_VZ = 57344;
__device__ __forceinline__ void hgrn_b1_dma(LAS unsigned char* L, const bf16_t* Fg, const bf16_t* Vg, int tid) {
    const int wid = __builtin_amdgcn_readfirstlane(tid >> 6), lane = tid & 63;
#pragma unroll
    for (int i = 0; i < 2; ++i) {
        const int p = wid * 64 + i * 512 + lane, row = p >> 4, c8 = p & 15;
        __builtin_amdgcn_global_load_lds((const unsigned*)(Fg + (size_t)row * DM + c8 * 8), (LAS unsigned*)(L + B1_FZ + (wid * 64 + i * 512) * 16), 16, 0, 0);
        __builtin_amdgcn_global_load_lds((const unsigned*)(Vg + (size_t)row * DM + c8 * 8), (LAS unsigned*)(L + B1_VZ + (wid * 64 + i * 512) * 16), 16, 0, 0);
    }
}
__device__ __forceinline__ void hgrn_b1_unit(LAS unsigned char* L, bf16_t* Sout, float* Dout, float (&sst)[8][4], float& cumdec, const float lb, int tid, bool has_next, const bf16_t* nFg, const bf16_t* nVg) {
    constexpr int KET = 0, VT = 18432, TS = 36864;
    const int wid = tid >> 6, lane = tid & 63, fr = lane & 15, fq = lane >> 4;
    const int k = tid & 127, J = tid >> 7;
    unsigned short zf[16], zv[16];
#pragma unroll
    for (int j = 0; j < 16; ++j) { zv[j] = *(const LAS unsigned short*)(L + B1_VZ + (16 * J + j) * 256 + k * 2); zf[j] = *(const LAS unsigned short*)(L + B1_FZ + (16 * J + j) * 256 + k * 2); }
    const float oml = 1.0f - lb;
    float E[16], kk[16]; float run = 1.f;
#pragma unroll
    for (int j = 0; j < 16; ++j) {
        const float z = bf2f(zf[j]), e = __expf(-z), sig = fast_rcp(1.0f + e), f = lb + oml * sig;
        kk[j] = oml * e * sig; run *= f; E[j] = run;
    }
    *(LAS float*)(L + TS + (J * 128 + k) * 4) = run;
#pragma unroll
    for (int j = 0; j < 2; ++j) {
        u32x4 w; w.x = zv[8 * j] | ((unsigned)zv[8 * j + 1] << 16); w.y = zv[8 * j + 2] | ((unsigned)zv[8 * j + 3] << 16); w.z = zv[8 * j + 4] | ((unsigned)zv[8 * j + 5] << 16); w.w = zv[8 * j + 6] | ((unsigned)zv[8 * j + 7] << 16);
        *(LAS u32x4*)(L + VT + k * 144 + J * 32 + j * 16) = w;
    }
    __syncthreads();
    if (has_next) hgrn_b1_dma(L, nFg, nVg, tid);
    const float t0 = *(LAS float*)(L + TS + k * 4), t1 = *(LAS float*)(L + TS + (128 + k) * 4), t2 = *(LAS float*)(L + TS + (256 + k) * 4), t3 = *(LAS float*)(L + TS + (384 + k) * 4);
    const float tail = (J < 1 ? t1 : 1.f) * (J < 2 ? t2 : 1.f) * (J < 3 ? t3 : 1.f);
    {
        const float rt = run * tail;
        unsigned pk[8];
#pragma unroll
        for (int j = 0; j < 16; j += 2) pk[j >> 1] = cvt_pk_bf16(kk[j] * fast_rcp(fmaxf(E[j], 1e-30f)) * rt, kk[j + 1] * fast_rcp(fmaxf(E[j + 1], 1e-30f)) * rt);
        *(LAS u32x4*)(L + KET + k * 144 + J * 32) = (u32x4){pk[0], pk[1], pk[2], pk[3]};
        *(LAS u32x4*)(L + KET + k * 144 + J * 32 + 16) = (u32x4){pk[4], pk[5], pk[6], pk[7]};
    }
    if (J == 0) { Dout[k] = cumdec; cumdec *= (t0 * t1) * (t2 * t3); }
    __syncthreads();
    {
        bf16x8 xa[2];
#pragma unroll
        for (int ks = 0; ks < 2; ++ks) xa[ks] = *(const LAS bf16x8*)(L + KET + (16 * wid + fr) * 144 + (ks * 32 + fq * 8) * 2);
        f32x4 dk = *(const LAS f32x4*)(L + TS + (16 * wid + 4 * fq) * 4);
        dk = dk * *(const LAS f32x4*)(L + TS + (128 + 16 * wid + 4 * fq) * 4); dk = dk * *(const LAS f32x4*)(L + TS + (256 + 16 * wid + 4 * fq) * 4); dk = dk * *(const LAS f32x4*)(L + TS + (384 + 16 * wid + 4 * fq) * 4);
#pragma unroll
        for (int vt = 0; vt < 8; ++vt) {
            f32x4 acc = (f32x4){0.f, 0.f, 0.f, 0.f};
#pragma unroll
            for (int ks = 0; ks < 2; ++ks) {
                const bf16x8 yb = *(const LAS bf16x8*)(L + VT + (16 * vt + fr) * 144 + (ks * 32 + fq * 8) * 2);
                acc = __builtin_amdgcn_mfma_f32_16x16x32_bf16(xa[ks], yb, acc, 0, 0, 0);
            }
            u32x2 o; o.x = cvt_pk_bf16(sst[vt][0], sst[vt][1]); o.y = cvt_pk_bf16(sst[vt][2], sst[vt][3]);
            *(u32x2*)(Sout + (size_t)(16 * vt + fr) * 128 + 16 * wid + 4 * fq) = o;
#pragma unroll
            for (int i = 0; i < 4; ++i) sst[vt][i] = dk[i] * sst[vt][i] + acc[i];
        }
    }
    asm volatile("s_waitcnt vmcnt(0)" ::: "memory");
    __syncthreads();
}

constexpr int B3_FZ = 107008, B3_QZ = 123392, B3_VZ = 86528;
__device__ __forceinline__ void hgrn_b3_dma_v(LAS unsigned char* L, const bf16_t* Vg, int tid) {
    const int wid = __builtin_amdgcn_readfirstlane(tid >> 6), lane = tid & 63;
#pragma unroll
    for (int i = 0; i < 2; ++i) {
        const int p = wid * 64 + i * 512 + lane, row = p >> 4, c8 = p & 15;
        __builtin_amdgcn_global_load_lds((const unsigned*)(Vg + (size_t)row * DM + c8 * 8), (LAS unsigned*)(L + B3_VZ + (wid * 64 + i * 512) * 16), 16, 0, 0);
    }
}
__device__ __forceinline__ void hgrn_b3_dma(LAS unsigned char* L, const bf16_t* Qg, const bf16_t* Fg, int tid) {
    const int wid = __builtin_amdgcn_readfirstlane(tid >> 6), lane = tid & 63;
#pragma unroll
    for (int i = 0; i < 2; ++i) {
        const int p = wid * 64 + i * 512 + lane, row = p >> 4, c8 = p & 15;
        __builtin_amdgcn_global_load_lds((const unsigned*)(Fg + (size_t)row * DM + c8 * 8), (LAS unsigned*)(L + B3_FZ + (wid * 64 + i * 512) * 16), 16, 0, 0);
        __builtin_amdgcn_global_load_lds((const unsigned*)(Qg + (size_t)row * DM + c8 * 8), (LAS unsigned*)(L + B3_QZ + (wid * 64 + i * 512) * 16), 16, 0, 0);
    }
}
__device__ __forceinline__ void hgrn_b3_unit(LAS unsigned char* L, bf16_t* Vg, const bf16_t* ZOg, const bf16_t* Sin, const f32x4 (&sq0)[4], const f32x4 (&sq1)[4], const float* Dc,
                                             const float lb, const float* ng, int tid, bool has_next, const bf16_t* nQg, const bf16_t* nFg, const bf16_t* nVg) {
    constexpr int QE = 0, QP = 25600, KP = 43008, VT = 86528, TS = 104960, OO = KP;
    const int wid = tid >> 6, lane = tid & 63, fr = lane & 15, fq = lane >> 4;
    bf16x8 ybS[4];
    bf16x8 pfq[4]; f32x4 dq0[4], dq1[4];
#pragma unroll
    for (int ks = 0; ks < 4; ++ks) {
        pfq[ks] = *(const bf16x8*)(Sin + (size_t)(16 * wid + fr) * 128 + ks * 32 + fq * 8);
        dq0[ks] = *(const f32x4*)(Dc + ks * 32 + fq * 8); dq1[ks] = *(const f32x4*)(Dc + ks * 32 + fq * 8 + 4);
    }
    const int te = tid >> 3, v0e = (tid & 7) * 16;
    const u32x4 z0 = *(const u32x4*)(ZOg + (size_t)te * DM + v0e), z1 = *(const u32x4*)(ZOg + (size_t)te * DM + v0e + 8);
    {
        const int k = tid & 127, J = tid >> 7;
        unsigned short zv[16], zf[16], zq[16];
#pragma unroll
        for (int j = 0; j < 16; ++j) zv[j] = *(const LAS unsigned short*)(L + B3_VZ + (16 * J + j) * 256 + k * 2);
#pragma unroll
        for (int j = 0; j < 16; ++j) { zf[j] = *(const LAS unsigned short*)(L + B3_FZ + (16 * J + j) * 256 + k * 2); zq[j] = *(const LAS unsigned short*)(L + B3_QZ + (16 * J + j) * 256 + k * 2); }
        const float oml = 1.0f - lb;
        float E[16], kk[16], qp[16]; float run = 1.f;
#pragma unroll
        for (int j = 0; j < 16; ++j) {
            const float z = bf2f(zf[j]), e = __expf(-z), sig = fast_rcp(1.0f + e), f = lb + oml * sig;
            kk[j] = oml * e * sig; run *= f; E[j] = run;
            qp[j] = bf2f(zq[j]) * run;
            *(LAS unsigned short*)(L + QP + (16 * J + j) * 272 + k * 2) = (unsigned short)(cvt_pk_bf16(qp[j], 0.f) & 0xffffu);
        }
        *(LAS float*)(L + TS + (J * 128 + k) * 4) = run;
        __syncthreads();
        if (has_next) hgrn_b3_dma(L, nQg, nFg, tid);
#pragma unroll
        for (int ks = 0; ks < 4; ++ks) {
            float v[8];
#pragma unroll
            for (int e = 0; e < 4; ++e) { v[e] = bf2f((unsigned)(unsigned short)pfq[ks][e]) + dq0[ks][e] * sq0[ks][e]; v[4 + e] = bf2f((unsigned)(unsigned short)pfq[ks][4 + e]) + dq1[ks][e] * sq1[ks][e]; }
            const u32x4 w = (u32x4){cvt_pk_bf16(v[0], v[1]), cvt_pk_bf16(v[2], v[3]), cvt_pk_bf16(v[4], v[5]), cvt_pk_bf16(v[6], v[7])};
            ybS[ks] = __builtin_bit_cast(bf16x8, w);
        }
#pragma unroll
        for (int j = 0; j < 2; ++j) {
            u32x4 w; w.x = zv[8 * j] | ((unsigned)zv[8 * j + 1] << 16); w.y = zv[8 * j + 2] | ((unsigned)zv[8 * j + 3] << 16); w.z = zv[8 * j + 4] | ((unsigned)zv[8 * j + 5] << 16); w.w = zv[8 * j + 6] | ((unsigned)zv[8 * j + 7] << 16);
            *(LAS u32x4*)(L + VT + k * 144 + J * 32 + j * 16) = w;
        }
        const float t0 = *(LAS float*)(L + TS + k * 4), t1 = *(LAS float*)(L + TS + (128 + k) * 4), t2 = *(LAS float*)(L + TS + (256 + k) * 4);
        const float r1 = t0, r2 = t0 * t1, r3 = r2 * t2;
        const float erj = J == 0 ? 1.f : (J == 1 ? r1 : (J == 2 ? r2 : r3));
#pragma unroll
        for (int j = 0; j < 16; ++j) *(LAS unsigned short*)(L + QE + (16 * J + j) * 400 + k * 2) = (unsigned short)(cvt_pk_bf16(qp[j] * erj, 0.f) & 0xffffu);
        {
            float kd[16], ke[16];
#pragma unroll
            for (int j = 0; j < 16; ++j) { kd[j] = kk[j] * fast_rcp(fmaxf(E[j], 1e-30f)); ke[j] = kd[j] * run; }
            const float tA = J == 0 ? t1 : t2, tB = t2;
#pragma unroll
            for (int I = 0; I < 4; ++I) {
                if (I >= J) {
                    const float gI = (I - J <= 1) ? 1.f : ((I - J == 2) ? tA : tA * tB);
                    const int base = (I == 0 ? 0 : (I == 1 ? 16 : (I == 2 ? 48 : 96))) + 16 * J;
#pragma unroll
                    for (int j = 0; j < 16; ++j) {
                        const float v = (I == J) ? kd[j] : ke[j] * gI;
                        *(LAS unsigned short*)(L + KP + (base + j) * 272 + k * 2) = (unsigned short)(cvt_pk_bf16(v, 0.f) & 0xffffu);
                    }
                }
            }
        }
    }
    __syncthreads();
#pragma unroll
    for (int rep = 0; rep < 2; ++rep) {
        const int idx = wid + 8 * rep, I = idx >> 2, Jt = idx & 3;
        u32x2 o = (u32x2){0u, 0u};
        if (Jt <= I) {
            const int base = (I == 0 ? 0 : (I == 1 ? 16 : (I == 2 ? 48 : 96))) + 16 * Jt;
            f32x4 acc = (f32x4){0.f, 0.f, 0.f, 0.f};
#pragma unroll
            for (int ks = 0; ks < 4; ++ks) {
                const bf16x8 xa = *(const LAS bf16x8*)(L + KP + (base + fr) * 272 + (ks * 32 + fq * 8) * 2);
                const bf16x8 yb = *(const LAS bf16x8*)(L + QP + (16 * I + fr) * 272 + (ks * 32 + fq * 8) * 2);
                acc = __builtin_amdgcn_mfma_f32_16x16x32_bf16(xa, yb, acc, 0, 0, 0);
            }
            if (Jt == I) {
#pragma unroll
                for (int i = 0; i < 4; ++i) if (4 * fq + i > fr) acc[i] = 0.f;
            }
            o.x = cvt_pk_bf16(acc[0], acc[1]); o.y = cvt_pk_bf16(acc[2], acc[3]);
        }
        *(LAS u32x2*)(L + QE + (16 * I + fr) * 400 + (128 + 16 * Jt + 4 * fq) * 2) = o;
    }
    __syncthreads();
    const f32x4 g0 = *(const f32x4*)(ng + v0e), g1 = *(const f32x4*)(ng + v0e + 4), g2 = *(const f32x4*)(ng + v0e + 8), g3 = *(const f32x4*)(ng + v0e + 12);
    {
        bf16x8 yb[6];
#pragma unroll
        for (int ks = 0; ks < 4; ++ks) yb[ks] = ybS[ks];
#pragma unroll
        for (int ks = 0; ks < 2; ++ks) yb[4 + ks] = *(const LAS bf16x8*)(L + VT + (16 * wid + fr) * 144 + (ks * 32 + fq * 8) * 2);
        f32x4 acc[4];
#pragma unroll
        for (int I = 0; I < 4; ++I) {
            acc[I] = (f32x4){0.f, 0.f, 0.f, 0.f};
#pragma unroll
            for (int ks = 0; ks < 6; ++ks) {
                const bf16x8 xa = *(const LAS bf16x8*)(L + QE + (16 * I + fr) * 400 + (ks * 32 + fq * 8) * 2);
                acc[I] = __builtin_amdgcn_mfma_f32_16x16x32_bf16(xa, yb[ks], acc[I], 0, 0, 0);
            }
        }
#pragma unroll
        for (int I = 0; I < 4; ++I)
#pragma unroll
            for (int i = 0; i < 4; ++i) *(LAS float*)(L + OO + (16 * I + 4 * fq + i) * 528 + (16 * wid + fr) * 4) = acc[I][i];
    }
    __syncthreads();
    if (has_next) hgrn_b3_dma_v(L, nVg, tid);
    {
        const int t = te, v0 = v0e;
        f32x4 ov[4]; float ss = 0.f;
#pragma unroll
        for (int j = 0; j < 4; ++j) { ov[j] = *(const LAS f32x4*)(L + OO + t * 528 + (v0 + 4 * j) * 4); ss += (ov[j][0] * ov[j][0] + ov[j][1] * ov[j][1]) + (ov[j][2] * ov[j][2] + ov[j][3] * ov[j][3]); }
        ss += __shfl_xor(ss, 1); ss += __shfl_xor(ss, 2); ss += __shfl_xor(ss, 4);
        const float rstd = rsqrtf(ss * (1.0f / 128.0f) + EPS);
        u32x4 w0, w1;
        w0.x = cvt_pk_bf16(ov[0][0] * rstd * g0[0] * bf2f(z0.x & 0xffffu), ov[0][1] * rstd * g0[1] * bf2f(z0.x >> 16));
        w0.y = cvt_pk_bf16(ov[0][2] * rstd * g0[2] * bf2f(z0.y & 0xffffu), ov[0][3] * rstd * g0[3] * bf2f(z0.y >> 16));
        w0.z = cvt_pk_bf16(ov[1][0] * rstd * g1[0] * bf2f(z0.z & 0xffffu), ov[1][1] * rstd * g1[1] * bf2f(z0.z >> 16));
        w0.w = cvt_pk_bf16(ov[1][2] * rstd * g1[2] * bf2f(z0.w & 0xffffu), ov[1][3] * rstd * g1[3] * bf2f(z0.w >> 16));
        w1.x = cvt_pk_bf16(ov[2][0] * rstd * g2[0] * bf2f(z1.x & 0xffffu), ov[2][1] * rstd * g2[1] * bf2f(z1.x >> 16));
        w1.y = cvt_pk_bf16(ov[2][2] * rstd * g2[2] * bf2f(z1.y & 0xffffu), ov[2][3] * rstd * g2[3] * bf2f(z1.y >> 16));
        w1.z = cvt_pk_bf16(ov[3][0] * rstd * g3[0] * bf2f(z1.z & 0xffffu), ov[3][1] * rstd * g3[1] * bf2f(z1.z >> 16));
        w1.w = cvt_pk_bf16(ov[3][2] * rstd * g3[2] * bf2f(z1.w & 0xffffu), ov[3][3] * rstd * g3[3] * bf2f(z1.w >> 16));
        *(u32x4*)(Vg + (size_t)t * DM + v0) = w0; *(u32x4*)(Vg + (size_t)t * DM + v0 + 8) = w1;
    }
    asm volatile("s_waitcnt vmcnt(0)" ::: "memory");
    __syncthreads();
}


#define XB_TMO      128
#define XB_XCNT(j)  (256  + 64 * (j))
#define XB_XSUB(j)  (1280 + 64 * (j))
#define XB_XGEN(j)  (2304 + 64 * (j))
#define XB_TOP      3328
#define XB_TOPGEN   3392
#define XCD_BAR_WORDS 3456
#define XB_SPIN_CAP (1u << 22)
__device__ __forceinline__ unsigned xb_ld(unsigned* p)              { return __hip_atomic_load(p, __ATOMIC_RELAXED, __HIP_MEMORY_SCOPE_AGENT); }
__device__ __forceinline__ unsigned xb_add(unsigned* p, unsigned v) { return __hip_atomic_fetch_add(p, v, __ATOMIC_RELAXED, __HIP_MEMORY_SCOPE_AGENT); }
__device__ __forceinline__ unsigned xb_xcc_id() { return (unsigned)__builtin_amdgcn_s_getreg((3 << 11) | 20) & 0xFu; }
#define XB_SPIN(cond, bar) do { unsigned _sp = 0; while (cond) { __builtin_amdgcn_s_sleep(1); \
    if ((++_sp & 255u) == 0u) { if (xb_ld(&(bar)[XB_TMO])) break; if (_sp > XB_SPIN_CAP) { atomicAdd(&(bar)[XB_TMO], 1u); break; } } } } while (0)
struct XcdBarrier { unsigned* bar; unsigned x; volatile LAS unsigned* st; };
__device__ __forceinline__ XcdBarrier xcd_barrier_post(unsigned* bar, volatile LAS unsigned* st) {
    XcdBarrier b; b.bar = bar; b.x = xb_xcc_id(); b.st = st;
    if (threadIdx.x == 0) (void)xb_add(&bar[XB_XCNT(b.x)], 1u);
    return b;
}
__device__ __forceinline__ void xcd_barrier_complete(unsigned* bar, unsigned x, unsigned& nloc, unsigned& nx) {
    const unsigned G = gridDim.x * gridDim.y * gridDim.z;
    unsigned sum, cnt, mine, sp = 0u;
    for (;;) {
        sum = 0u; cnt = 0u; mine = 0u;
#pragma unroll
        for (unsigned j = 0; j < 16; ++j) { const unsigned c = xb_ld(&bar[XB_XCNT(j)]); sum += c; cnt += (c > 0u) ? 1u : 0u; mine = (j == x) ? c : mine; }
        if (sum == G) break;
        __builtin_amdgcn_s_sleep(1);
        if ((++sp & 255u) == 0u) { if (xb_ld(&bar[XB_TMO])) break; if (sp > XB_SPIN_CAP) { atomicAdd(&bar[XB_TMO], 1u); break; } }
    }
    nloc = mine > 0u ? mine : 1u; nx = cnt > 0u ? cnt : 1u;
}
__device__ __forceinline__ void xcd_barrier(const XcdBarrier& b) {
    asm volatile("s_waitcnt vmcnt(0)" ::: "memory");
    __syncthreads();
    if (threadIdx.x == 0) {
        unsigned* bar = b.bar;
        __builtin_amdgcn_s_waitcnt(0);
        unsigned nloc = b.st[0], nx = b.st[1];
        if (nloc == 0u) { xcd_barrier_complete(bar, b.x, nloc, nx); b.st[0] = nloc; b.st[1] = nx; }
        const unsigned old = xb_add(&bar[XB_XSUB(b.x)], 1u);
        const unsigned gen = old / nloc;
        if (old + 1u == (gen + 1u) * nloc) {
            __builtin_amdgcn_fence(__ATOMIC_RELEASE, "agent");
            asm volatile("s_waitcnt vmcnt(0)" ::: "memory");
            const unsigned og = xb_add(&bar[XB_TOP], 1u);
            const unsigned tg = og / nx;
            if (og + 1u == (tg + 1u) * nx) xb_add(&bar[XB_TOPGEN], 1u);
            else XB_SPIN(xb_ld(&bar[XB_TOPGEN]) == tg, bar);
            __builtin_amdgcn_fence(__ATOMIC_ACQUIRE, "agent");
            xb_add(&bar[XB_XGEN(b.x)], 1u);
            asm volatile("s_waitcnt vmcnt(0)" ::: "memory");
        } else {
            XB_SPIN(xb_ld(&bar[XB_XGEN(b.x)]) == gen, bar);
            __builtin_amdgcn_fence(__ATOMIC_ACQUIRE, "agent");
            asm volatile("s_waitcnt vmcnt(0)" ::: "memory");
        }
    }
    __syncthreads();
}
constexpr size_t WS_BAR = 65536;

__global__ void __launch_bounds__(512, 2) mega_fwd(Args a) {
    unsigned char* ap_ws = a.ws;
    __shared__ __attribute__((aligned(16))) unsigned char lds_raw[LDS_BYTES];
    LAS unsigned char* L = (LAS unsigned char*)lds_raw;
    cg::grid_group grid = cg::this_grid();
    volatile LAS unsigned* bst = (volatile LAS unsigned*)(L + LDS_BYTES - 16);
    if (threadIdx.x < 2) bst[threadIdx.x] = 0u;
    __syncthreads();
    (void)xcd_barrier_post((unsigned*)(ap_ws + WS_BAR), bst);
    const int st_hi = a.hi;
    for (int st = a.lo; st < st_hi; ++st) {
        const __attribute__((address_space(4))) Args* kp = (const __attribute__((address_space(4))) Args*)__builtin_amdgcn_kernarg_segment_ptr();
        asm volatile("" : "+s"(kp));
        if (st != 0 && st != 9 && st != 18 && (st - 1 - (st > 9 ? 9 : 0)) == 2) continue;
#define a (*kp)
        int tid = threadIdx.x; asm volatile("" : "+v"(tid));
        int bx = blockIdx.x; asm volatile("" : "+s"(bx));
        int G = gridDim.x; asm volatile("" : "+s"(G));
        const int lane = tid & 63, wave = __builtin_amdgcn_readfirstlane(tid >> 6);
        unsigned char* ws = a.ws;
        const float* x_in = a.in[0];
        float* lbv = (float*)(ws + WS_LBV);
        bf16_t* XB = (bf16_t*)(ws + WS_XB); float* SSP = (float*)(ws + WS_SSP);
        unsigned char* P = ws + WS_P;
        bf16_t *bU = (bf16_t*)(P + P_U), *bV = (bf16_t*)(P + P_V), *bQ = (bf16_t*)(P + P_Q), *bF = (bf16_t*)(P + P_F), *bI = (bf16_t*)(P + P_I), *bZO = (bf16_t*)(P + P_ZO),
               *bS = (bf16_t*)a.out  , *MIX = bQ  ;
        const unsigned char *bGA = P + P_GA, *bGB = P + P_GB;
        f32x2* bVST = (f32x2*)(P + P_VST); float* bD = (float*)(P + P_D);
        bf16_t* H1 = (bf16_t*)(ws + WS_H1);
        if (st >= 100) {
#ifdef DBG_OFF
            const bf16_t* src = (const bf16_t*)(ws + (size_t)DBG_OFF);
            for (size_t i = (size_t)bx * 512 + tid; i < (size_t)MTOT * DM; i += (size_t)G * 512) a.out[i] = bf2f(src[i]);
#endif
        } else if (st == 0 || st == 9) {
            const int wlayer = st == 0 ? 0 : 1;
            const int gw = bx * 8 + wave, NGW = G * 8;
            {
                LAS float* T = (LAS float*)L;
                f32x4 v[8];
                int it = bx;
                { const P0Item p = p0_decode(kp, it < P0_NITEMS ? it : P0_NITEMS - 1, wlayer); p0_load(p, v, wave, lane); }
                while (it < P0_NITEMS) {
                    const P0Item p = p0_decode(kp, it, wlayer);
#pragma unroll
                    for (int i = 0; i < 8; ++i)
#pragma unroll
                        for (int e = 0; e < 4; ++e) T[(wave * 8 + i) * 257 + lane * 4 + e] = v[i][e];
                    __syncthreads();
                    const int nx = it + G;
                    if (nx < P0_NITEMS) { const P0Item q = p0_decode(kp, nx, wlayer); p0_load(q, v, wave, lane); }
#pragma unroll
                    for (int j = 0; j < 4; ++j) {
                        const int q = tid + j * 512, n = q >> 3, c = q & 7;
                        const LAS float* t = T + (8 * c) * 257 + n;
                        u32x4 o; o.x = cvt_pk_bf16(t[0], t[257]); o.y = cvt_pk_bf16(t[2 * 257], t[3 * 257]); o.z = cvt_pk_bf16(t[4 * 257], t[5 * 257]); o.w = cvt_pk_bf16(t[6 * 257], t[7 * 257]);
                        *(u32x4*)(p.WT + (size_t)(p.n0 + n) * p.K + p.k0 + 8 * c) = o;
                    }
                    __syncthreads();
                    it = nx;
                }
            }
            const int m_end = st == 0 ? MTOT : 0;
            for (int m0 = gw; m0 < m_end; m0 += 4 * NGW) {
                f32x4 v[4][4];
#pragma unroll
                for (int r = 0; r < 4; ++r) {
                    const int m = m0 + r * NGW < MTOT ? m0 + r * NGW : m0;
                    const f32x4* xr = (const f32x4*)(x_in + (size_t)m * DM) + lane;
#pragma unroll
                    for (int j = 0; j < 4; ++j) v[r][j] = __builtin_nontemporal_load(&xr[64 * j]);
                }
#pragma unroll
                for (int r = 0; r < 4; ++r) {
                    const int m = m0 + r * NGW;
                    float sq = 0.f;
#pragma unroll
                    for (int j = 0; j < 4; ++j) sq += (v[r][j][0] * v[r][j][0] + v[r][j][1] * v[r][j][1]) + (v[r][j][2] * v[r][j][2] + v[r][j][3] * v[r][j][3]);
                    sq = wave_sum(sq);
                    if (m < MTOT) {
                        u32x2* o8 = (u32x2*)(XB + (size_t)m * DM) + lane;
#pragma unroll
                        for (int j = 0; j < 4; ++j) o8[64 * j] = (u32x2){cvt_pk_bf16(v[r][j][0], v[r][j][1]), cvt_pk_bf16(v[r][j][2], v[r][j][3])};
                        if (lane == 0) *(f32x4*)(SSP + (size_t)m * 4) = (f32x4){sq, 0.f, 0.f, 0.f};
                    }
                }
            }
            for (int i = bx * 512 + tid; i < (st == 0 ? 2048 : 0); i += G * 512) {
                const int c = i & 1023;
                lbv[i] = (i < 1024) ? 0.f : fast_rcp(1.0f + __expf(a.in[7][c] - a.in[7][1024 + c]));
            }
        } else if (st == 18) {
            const int gw = bx * 8 + wave, NGW = G * 8;
            const float* fn = a.in[15];
            f32x4 gq[4];
#pragma unroll
            for (int j = 0; j < 4; ++j) gq[j] = *((const f32x4*)fn + 64 * j + lane);
            for (int m0 = gw; m0 < MTOT; m0 += 4 * NGW) {
                u32x2 xv[4][4]; f32x4 pp[4];
#pragma unroll
                for (int r = 0; r < 4; ++r) {
                    const int m = m0 + r * NGW < MTOT ? m0 + r * NGW : m0;
                    const u32x2* xr = (const u32x2*)(XB + (size_t)m * DM) + lane;
#pragma unroll
                    for (int j = 0; j < 4; ++j) xv[r][j] = __builtin_nontemporal_load(&xr[64 * j]);
                    pp[r] = *(const f32x4*)(SSP + (size_t)m * 4);
                }
#pragma unroll
                for (int r = 0; r < 4; ++r) {
                    const int m = m0 + r * NGW;
                    if (m < MTOT) {
                        const float rstd = rstd4(pp[r]);
                        f32x4* orow = (f32x4*)(a.out + (size_t)m * DM) + lane;
#pragma unroll
                        for (int j = 0; j < 4; ++j) {
                            const f32x4 v = (f32x4){bf2f(xv[r][j].x & 0xffffu), bf2f(xv[r][j].x >> 16), bf2f(xv[r][j].y & 0xffffu), bf2f(xv[r][j].y >> 16)};
                            __builtin_nontemporal_store(v * rstd * gq[j], &orow[64 * j]);
                        }
                    }
                }
            }
        } else {
            const int l = st > 9 ? 1 : 0, k = st - 1 - 9 * l;
            unsigned char* wl = ws + WS_W;
            if (k < 5) {
                const int kind = k;
                if (kind == 0) {
                    pg8::Gemm g{XB, (const bf16_t*)(wl + WL_IN), MTOT, INC, DM};
                    pg8::StaticOrder S; S.init(MTOT, INC, G, bx);
                    EpiInProj E{SSP, P, bVST};

#ifndef NO_P1
                    for (int rep_ = 0; rep_ < DUP_P1; ++rep_) { pg8::gemm_phase<EpiInProj>(L, g, S, E, tid); asm volatile("s_waitcnt vmcnt(0)" ::: "memory"); __syncthreads(); }
#endif

                } else if (kind == 1) {
                    for (int u = bx; u < 1024; u += G) {
                        const int g = u & 3, blk = u >> 2;

#ifndef NO_GM
                        gmlp_unit(L, bU, bV, bVST, a.in[4] + (size_t)(l * 4 + g) * 16384, a.in[5] + (l * 4 + g) * 128, a.in[2] + l * GW, a.in[3] + l * GW, blk * 128, g, tid);
#endif

                    }
                    for (int sg = bx; sg < 256; sg += G) {
                        const int bh = sg >> 2, seg = sg & 3, hh = bh & 7, bl = bh >> 3, c0 = seg * 16;
                        const size_t toff0 = (size_t)(bl * SEQ + c0 * 64) * DM + hh * 128;
                        hgrn_b1_dma(L, bF + toff0, bI + toff0, tid);
                        asm volatile("s_waitcnt vmcnt(0)" ::: "memory");
                        __syncthreads();
                        float sst[8][4]; float cumdec = 1.f;
                        const float lb1 = lbv[l * 1024 + hh * 128 + (tid & 127)];
#pragma unroll
                        for (int vt = 0; vt < 8; ++vt)
#pragma unroll
                            for (int i = 0; i < 4; ++i) sst[vt][i] = 0.f;
                        for (int i = 0; i < 16; ++i) {
                            const int u = bh * 64 + c0 + i; const bool hn = i < 15;
                            const size_t toffn = toff0 + (size_t)(hn ? i + 1 : i) * 64 * DM;
                            hgrn_b1_unit(L, bS + (size_t)u * 16384, bD + (size_t)u * 128, sst, cumdec, lb1, tid, hn, bF + toffn, bI + toffn);
                        }
                        {
                            const int wid = tid >> 6, fr = tid & 15, fq = (tid & 63) >> 4;
                            float* sb = (float*)(P + P_SEGB) + (size_t)sg * 16384;
#pragma unroll
                            for (int vt = 0; vt < 8; ++vt) *(f32x4*)(sb + (size_t)(16 * vt + fr) * 128 + 16 * wid + 4 * fq) = (f32x4){sst[vt][0], sst[vt][1], sst[vt][2], sst[vt][3]};
                            if (tid < 128) ((float*)(P + P_SEGA))[(size_t)sg * 128 + tid] = cumdec;
                        }
                    }
                } else if (kind == 2) {
                } else if (kind == 3) {
                    for (int sg = bx; sg < 256; sg += G) {
                        const int wid = tid >> 6, fr = tid & 15, fq = (tid & 63) >> 4;
                        const int bh = sg >> 2, seg = sg & 3, hh = bh & 7, bl = bh >> 3, c0 = seg * 16;
                        const size_t toff0 = (size_t)(bl * SEQ + c0 * 64) * DM + hh * 128;
                        hgrn_b3_dma(L, bQ + toff0, bF + toff0, tid);
                        hgrn_b3_dma_v(L, bI + toff0, tid);
                        f32x4 sq0[4], sq1[4];
                        {
                            float z_ = 0.f; asm volatile("" : "+v"(z_));
#pragma unroll
                            for (int ks = 0; ks < 4; ++ks) { sq0[ks] = (f32x4){z_, z_, z_, z_}; sq1[ks] = (f32x4){z_, z_, z_, z_}; }
                            for (int j = 0; j < seg; ++j) {
                                const float* sbj = (const float*)(P + P_SEGB) + (size_t)(bh * 4 + j) * 16384 + (size_t)(16 * wid + fr) * 128 + fq * 8;
                                const float* saj = (const float*)(P + P_SEGA) + (size_t)(bh * 4 + j) * 128 + fq * 8;
#pragma unroll
                                for (int ks = 0; ks < 4; ++ks) {
                                    sq0[ks] = *(const f32x4*)(saj + ks * 32) * sq0[ks] + *(const f32x4*)(sbj + ks * 32);
                                    sq1[ks] = *(const f32x4*)(saj + ks * 32 + 4) * sq1[ks] + *(const f32x4*)(sbj + ks * 32 + 4);
                                }
                            }
                        }
                        const float lb3 = lbv[l * 1024 + hh * 128 + (tid & 127)];
                        asm volatile("s_waitcnt vmcnt(0)" ::: "memory");
                        __syncthreads();
                        for (int i = 0; i < 16; ++i) {
                            const int u = bh * 64 + c0 + i; const bool hn = i < 15;
                            const size_t toff = toff0 + (size_t)i * 64 * DM, toffn = toff0 + (size_t)(hn ? i + 1 : i) * 64 * DM;
                            hgrn_b3_unit(L, bI + toff, bZO + toff, bS + (size_t)u * 16384, sq0, sq1, bD + (size_t)u * 128, lb3, a.in[8] + l * 128, tid, hn, bQ + toffn, bF + toffn, bI + toffn);
                        }
                    }
                } else {
                    for (int pass = 0; pass < 2; ++pass) {
                        pg8::Gemm g{pass == 0 ? bU : bI, (const bf16_t*)(wl + (pass == 0 ? WL_A : WL_B)), MTOT, DM, pass == 0 ? GW : DM};
                        pg8::StaticOrder S; S.init(MTOT, DM, G, bx);
                        EpiMix E{pass == 0 ? bGA : bGB, MIX, pass == 0 ? 1 : 0};

#ifndef NO_P3
                        pg8::gemm_phase<EpiMix>(L, g, S, E, tid);
#endif

                    }
                }
            } else if (k == 5 || k == 7) {
                pg8::Gemm g{k == 5 ? MIX : H1, (const bf16_t*)(wl + (k == 5 ? WL_O : WL_2)), MTOT, DM, k == 5 ? DM : DFF};
                pg8::StaticOrder S; S.init(MTOT, DM, G, bx);
                EpiResid E{XB, SSP, L + 131072};

#ifndef NO_P4
                pg8::gemm_phase<EpiResid>(L, g, S, E, tid);
#endif

            } else {
                pg8::Gemm g{XB, (const bf16_t*)(wl + WL_1), MTOT, DFF, DM};
                pg8::StaticOrder S; S.init(MTOT, DFF, G, bx);
                EpiFF1 E{SSP, H1};

#ifndef NO_P5
                pg8::gemm_phase<EpiFF1>(L, g, S, E, tid);
#endif

            }
        }
#undef a
        if (st + 1 < st_hi) {
            if (st_hi > 1000) grid.sync();
            else { XcdBarrier xbar; xbar.bar = (unsigned*)(kp->ws + WS_BAR); xbar.x = xb_xcc_id(); xbar.st = (volatile LAS unsigned*)(L + LDS_BYTES - 16); xcd_barrier(xbar); }
        }
    }
}

extern "C" void kernel_launch(void* const* d_in, const int* in_sizes, int n_in, void* d_out, int out_size, void* d_ws, size_t ws_size, hipStream_t stream) {
    static int grid = 0;
    if (grid == 0) {
        if (n_in != 16 || out_size != MTOT * DM || ws_size < WS_END) { fprintf(stderr, "kernel_launch: unexpected shapes / workspace (%d inputs, out %d, ws %zu < %zu)\n", n_in, out_size, ws_size, (size_t)WS_END); grid = -1; return; }
        int dev = 0, cus = 0, per_cu = 0;
        hipGetDevice(&dev); hipDeviceGetAttribute(&cus, hipDeviceAttributeMultiprocessorCount, dev);
        hipOccupancyMaxActiveBlocksPerMultiprocessor(&per_cu, (const void*)mega_fwd, 512, 0);
        (void)hipGetLastError();
        if (per_cu < 1) per_cu = 1;
        grid = cus * 1;
        if (grid <= 0) grid = 256;
    }
    if (grid < 0) return;
    (void)hipMemsetAsync((char*)d_ws + WS_BAR, 0, 16384, stream);
    Args a{};
    for (int i = 0; i < 16; ++i) a.in[i] = (const float*)d_in[i];
    a.out = (float*)d_out; a.ws = (unsigned char*)d_ws;
#if MK_MULTI
#ifdef DBG_STOP
    for (int st = 0; st < DBG_STOP; ++st) { a.lo = st; a.hi = st + 1; hipLaunchKernelGGL(mega_fwd, dim3(grid), dim3(512), 0, stream, a); }
    a.lo = 100; a.hi = 101; hipLaunchKernelGGL(mega_fwd, dim3(grid), dim3(512), 0, stream, a);
#else
    for (int st = 0; st < 19; ++st) { a.lo = st; a.hi = st + 1; hipLaunchKernelGGL(mega_fwd, dim3(grid), dim3(512), 0, stream, a); }
#endif
#else
    a.lo = 0; a.hi = 19;
    void* args[] = {&a};
    hipError_t e = hipLaunchCooperativeKernel((const void*)mega_fwd, dim3(grid), dim3(512), args, 0, stream);
    if (e != hipSuccess) fprintf(stderr, "cooperative launch failed: %s (grid %d)\n", hipGetErrorString(e), grid);
#endif
}
```

```cpp
#include <hip/hip_runtime.h>
#include <hip/hip_cooperative_groups.h>
#include <cstdio>
#include <cstdint>
namespace cg = cooperative_groups;
#define MK_MULTI 0
#ifndef DUP_B1
#define DUP_B1 1
#endif
#ifndef DUP_P1
#define DUP_P1 1
#endif

#define LAS __attribute__((address_space(3)))
typedef unsigned short bf16_t;
typedef short bf16x8 __attribute__((ext_vector_type(8)));
typedef float f32x4 __attribute__((ext_vector_type(4)));
typedef float f32x2 __attribute__((ext_vector_type(2)));
typedef unsigned u32x4 __attribute__((ext_vector_type(4)));
typedef unsigned u32x2 __attribute__((ext_vector_type(2)));

constexpr int DM = 1024, BATCH = 8, SEQ = 4096, MTOT = BATCH * SEQ;
constexpr int INC = 7168, DFF = 4096, GW = 512;
constexpr float EPS = 1e-6f;

__device__ __forceinline__ float bf2f(unsigned v) { return __uint_as_float(v << 16); }
typedef __bf16 bf16x2_t __attribute__((ext_vector_type(2)));
__device__ __forceinline__ unsigned cvt_pk_bf16(float lo, float hi) { f32x2 v = {lo, hi}; bf16x2_t b = __builtin_convertvector(v, bf16x2_t); return __builtin_bit_cast(unsigned, b); }
__device__ __forceinline__ float fast_rcp(float x) { return __builtin_amdgcn_rcpf(x); }
__device__ __forceinline__ float sigmoidf_(float x) { return fast_rcp(1.0f + __expf(-x)); }
__device__ __forceinline__ float siluf_(float x) { return x * sigmoidf_(x); }
__device__ __forceinline__ f32x2 gelu_pk(f32x2 v) {
    const f32x2 av = __builtin_elementwise_abs(v), d = av * 0.2316418882f + 1.0f;
    f32x2 t; t.x = __builtin_amdgcn_rcpf(d.x); t.y = __builtin_amdgcn_rcpf(d.y);
    f32x2 q = t * 0.5307027145f + (-0.7265760135f); q = q * t + 0.7107068705f; q = q * t + (-0.142248368f); q = q * t + 0.127414796f; q = q * t;
    const f32x2 s = (v * v) * (-0.72134752044f);
    f32x2 e; e.x = __builtin_amdgcn_exp2f(s.x); e.y = __builtin_amdgcn_exp2f(s.y);
    const f32x2 m = v * (q * e), r = v - m;
    f32x2 o; o.x = v.x < 0.f ? m.x : r.x; o.y = v.y < 0.f ? m.y : r.y; return o;
}
__device__ __forceinline__ float wave_sum(float v) {
#pragma unroll
    for (int o = 1; o < 64; o <<= 1) v += __shfl_xor(v, o);
    return v;
}

namespace pg8 {
constexpr int BM = 256, BK = 64, HALF = 128, HTB = HALF * BK * 2, STAGE_BYTES = 8 * HTB, NXCD = 8, WGM = 8;
__host__ __device__ __forceinline__ int lds_byte(int r, int c) { const int st = (r >> 4) * 2 + (c >> 5), rr = r & 15, cc = c & 31, ob = rr * 64 + cc * 2; return st * 1024 + (ob ^ (((ob >> 9) & 1) << 5)); }
__host__ __device__ __forceinline__ void stage_rc(int b, int& R, int& C) { const int st = b / 1024, sb = b % 1024, swz = sb ^ (((sb >> 9) & 1) << 5); R = (st >> 1) * 16 + swz / 64; C = (st & 1) * 32 + (swz % 64) / 2; }
__host__ __device__ __forceinline__ int perm32(int rho) { const int n = rho >> 4, i = rho & 15; return 8 * (i >> 2) + 4 * n + (i & 3); }
struct Unit { int pm, pn; };
struct Gemm { const bf16_t* A; const bf16_t* Bt; int M, N, K; };
struct StaticOrder {
    int nM, nN, nwg, G, c;
    __device__ void init(int M, int N, int G_, int c_) { nM = M / BM; nN = N / BM; nwg = nM * nN; G = G_; c = c_; }
    __device__ bool next(int i, Unit& u) const {
        const long L = (long)i * G + c; if (L >= nwg) return false;
        int wgid = (int)L; { const int q = nwg / NXCD, r = nwg % NXCD, xcd = wgid % NXCD, off = wgid / NXCD; wgid = (xcd < r ? xcd * (q + 1) : r * (q + 1) + (xcd - r) * q) + off; }
        const int nig = WGM * nN, gid = wgid / nig, fm = gid * WGM, gsz = (nM - fm) < WGM ? (nM - fm) : WGM;
        u.pm = fm + ((wgid % nig) % gsz); u.pn = (wgid % nig) / gsz; return true;
    }
};
template <class Epi>
__device__ __forceinline__ void gemm_phase(LAS unsigned char* lds, const Gemm g, const StaticOrder& S, const Epi& E, const int tid) {
    const int wid = __builtin_amdgcn_readfirstlane(tid >> 6), lane = tid & 63, wr = wid >> 2, wc = wid & 3, fr = lane & 15, fq = lane >> 4;
    const int K = g.K, nt = K / BK;
    unsigned voffA[2], voffB[2];
#pragma unroll
    for (int i = 0; i < 2; ++i) { int R, C; stage_rc(tid * 16 + i * 8192, R, C); const int Rb = (R & ~31) + perm32(R & 31);
        voffA[i] = (unsigned)(R * K + C) * 2u; voffB[i] = (unsigned)(Rb * K + C) * 2u; }
    const size_t kstep = (size_t)(BK * 2);
    const size_t hstep = (size_t)HALF * K * 2;
    const size_t tstep = 2 * hstep;
    const unsigned ldsw = (unsigned)wid * 1024u;
    const int aoff = lds_byte(wr * 64 + fr, fq * 8), boff = lds_byte(wc * 32 + fr, fq * 8);
#define PG8_SA(b, h) (((b) * 2 + (h)) * HTB)
#define PG8_SB(b, h) ((4 + (b) * 2 + (h)) * HTB)
#define PG8_STAGE(bufoff, gbase, voff) do { _Pragma("unroll") for (int _i = 0; _i < 2; ++_i) \
        __builtin_amdgcn_global_load_lds((const unsigned*)((const char*)(gbase) + (voff)[_i]), (LAS unsigned*)(lds + (bufoff) + ldsw + _i * 8192), 16, 0, 0); } while (0)
#define PG8_LDA(dst, b, h) do { _Pragma("unroll") for (int m = 0; m < 4; ++m) _Pragma("unroll") for (int k = 0; k < 2; ++k) dst[m][k] = *(const LAS bf16x8*)(lds + PG8_SA(b, h) + aoff + m * 2048 + k * 1024); } while (0)
#define PG8_LDB(dst, b, h) do { _Pragma("unroll") for (int n = 0; n < 2; ++n) _Pragma("unroll") for (int k = 0; k < 2; ++k) dst[n][k] = *(const LAS bf16x8*)(lds + PG8_SB(b, h) + boff + n * 2048 + k * 1024); } while (0)
#define PG8_MMA(ai, bj, At, Bt) do { __builtin_amdgcn_s_setprio(1); _Pragma("unroll") for (int m = 0; m < 4; ++m) _Pragma("unroll") for (int n = 0; n < 2; ++n) _Pragma("unroll") for (int k = 0; k < 2; ++k) \
        acc[ai][bj][m][n] = __builtin_amdgcn_mfma_f32_16x16x32_bf16(Bt[n][k], At[m][k], acc[ai][bj][m][n], 0, 0, 0); __builtin_amdgcn_s_setprio(0); } while (0)
#define PG8_WAIT_V(n) asm volatile("s_waitcnt vmcnt(" #n ")" ::: "memory")
#define PG8_WAIT_L(n) asm volatile("s_waitcnt lgkmcnt(" #n ")" ::: "memory")
#define PG8_BAR __builtin_amdgcn_s_barrier()
#define PG8_SCHED __builtin_amdgcn_sched_barrier(0)
    Unit cur, nxt; int ui = 0;
    if (!S.next(0, cur)) return;
    f32x4 acc[2][2][4][2];
    E.init(acc, cur, wr, wc, fr, fq);
    bf16x8 At[4][2], B0[2][2], B1[2][2];
    const char* cA = (const char*)g.A + (size_t)cur.pm * tstep; const char* cB = (const char*)g.Bt + (size_t)cur.pn * tstep;
    PG8_STAGE(PG8_SB(0, 0), cB, voffB); PG8_STAGE(PG8_SB(0, 1), cB + hstep, voffB); PG8_STAGE(PG8_SA(0, 0), cA, voffA); PG8_STAGE(PG8_SA(0, 1), cA + hstep, voffA);
    if (wr == 1) PG8_BAR;
    PG8_WAIT_V(2); PG8_BAR;
    PG8_STAGE(PG8_SB(1, 0), cB + kstep, voffB); PG8_STAGE(PG8_SA(1, 0), cA + kstep, voffA); PG8_STAGE(PG8_SB(1, 1), cB + hstep + kstep, voffB);
    PG8_WAIT_V(6); PG8_BAR;
    for (;;) {
        const bool has_next = S.next(ui + 1, nxt);
        const char* nA = has_next ? (const char*)g.A + (size_t)nxt.pm * tstep : cA; const char* nB = has_next ? (const char*)g.Bt + (size_t)nxt.pn * tstep : cB;
        for (int t = 0; t < nt; t += 2) {
            const bool last = (t == nt - 2);
            const char* a1 = cA + (size_t)(t + 1) * kstep;
            const char* a2 = last ? nA : cA + (size_t)(t + 2) * kstep; const char* b2 = last ? nB : cB + (size_t)(t + 2) * kstep;
            const char* a3 = a2 + kstep; const char* b3 = b2 + kstep;
            PG8_LDB(B0, 0, 0); PG8_LDB(B1, 0, 1); PG8_SCHED; PG8_LDA(At, 0, 0); PG8_STAGE(PG8_SA(1, 1), a1 + hstep, voffA);
            PG8_WAIT_V(8); PG8_WAIT_L(0); PG8_BAR; PG8_MMA(0, 0, At, B0); PG8_MMA(0, 1, At, B1); PG8_BAR; PG8_SCHED;
            PG8_LDA(At, 0, 1); PG8_STAGE(PG8_SB(0, 0), b2, voffB); PG8_STAGE(PG8_SB(0, 1), b2 + hstep, voffB); PG8_STAGE(PG8_SA(0, 0), a2, voffA);
            PG8_WAIT_V(8); PG8_WAIT_L(0); PG8_BAR; PG8_MMA(1, 0, At, B0); PG8_MMA(1, 1, At, B1); PG8_BAR; PG8_SCHED;
            PG8_LDB(B0, 1, 0); PG8_LDB(B1, 1, 1); PG8_SCHED; PG8_LDA(At, 1, 0); PG8_STAGE(PG8_SA(0, 1), a2 + hstep, voffA);
            PG8_WAIT_V(8); PG8_WAIT_L(0); PG8_BAR; PG8_MMA(0, 0, At, B0); PG8_MMA(0, 1, At, B1); PG8_BAR; PG8_SCHED;
            PG8_LDA(At, 1, 1); PG8_STAGE(PG8_SB(1, 0), b3, voffB); PG8_STAGE(PG8_SB(1, 1), b3 + hstep, voffB); PG8_STAGE(PG8_SA(1, 0), a3, voffA);
            PG8_WAIT_V(8); PG8_WAIT_L(0); PG8_BAR; PG8_MMA(1, 0, At, B0); PG8_MMA(1, 1, At, B1); PG8_BAR; PG8_SCHED;
        }
        if (wr == 0) PG8_BAR;
        E(acc, cur, wr, wc, fr, fq);
        if (!has_next) break;
        E.init(acc, nxt, wr, wc, fr, fq);
        cur = nxt; cA = nA; cB = nB; ++ui;
        if (wr == 1) PG8_BAR;
    }
    PG8_WAIT_V(0);
    PG8_BAR;
#undef PG8_SA
#undef PG8_SB
#undef PG8_STAGE
#undef PG8_LDA
#undef PG8_LDB
#undef PG8_MMA
#undef PG8_WAIT_V
#undef PG8_WAIT_L
#undef PG8_BAR
#undef PG8_SCHED
}
}
using pg8::Unit;

constexpr size_t WS_LBV = 0;
constexpr size_t WS_W = 1u << 20;
constexpr size_t WL_IN = 0, WL_A = WL_IN + (size_t)INC * DM * 2, WL_B = WL_A + (size_t)DM * GW * 2, WL_O = WL_B + (size_t)DM * DM * 2,
                 WL_1 = WL_O + (size_t)DM * DM * 2, WL_2 = WL_1 + (size_t)DFF * DM * 2, WL_SIZE = WL_2 + (size_t)DM * DFF * 2;
constexpr size_t WS_XB = WS_W + WL_SIZE;
constexpr size_t WS_SSP = WS_XB + (size_t)MTOT * DM * 2;
constexpr size_t WS_P = WS_SSP + (size_t)MTOT * 16 * 4;
constexpr size_t P_U = 0, P_V = P_U + (size_t)MTOT * GW * 2, P_Q = P_V + (size_t)MTOT * GW * 2, P_F = P_Q + (size_t)MTOT * DM * 2, P_I = P_F + (size_t)MTOT * DM * 2,
                 P_ZO = P_I + (size_t)MTOT * DM * 2, P_GA = P_ZO + (size_t)MTOT * DM * 2, P_GB = P_GA + (size_t)MTOT * DM  , P_VST = P_GB + (size_t)MTOT * DM,
                 P_D = P_VST + (size_t)MTOT * 8 * 8, P_SEGB = P_D + (size_t)4096 * 128 * 4, P_SEGA = P_SEGB + (size_t)256 * 16384 * 4, P_END = P_SEGA + (size_t)256 * 128 * 4;
constexpr size_t WS_H1 = WS_P;
constexpr size_t WS_END = WS_P + (P_END > (size_t)MTOT * DFF * 2 ? P_END : (size_t)MTOT * DFF * 2);
static_assert(WS_END <= 536870912ull, "workspace map exceeds 512 MiB");

__device__ __forceinline__ float rstd4(const f32x4 p) { return rsqrtf(((p[0] + p[1]) + (p[2] + p[3])) * (1.0f / DM) + EPS); }

struct EpiInProj {
    const float* ssp; unsigned char* P; f32x2* vst;
    __device__ __forceinline__ void init(f32x4 (&acc)[2][2][4][2], const Unit&, int, int, int, int) const {
#pragma unroll
        for (int a_ = 0; a_ < 2; ++a_)
#pragma unroll
            for (int b_ = 0; b_ < 2; ++b_)
#pragma unroll
                for (int m_ = 0; m_ < 4; ++m_)
#pragma unroll
                    for (int n_ = 0; n_ < 2; ++n_) acc[a_][b_][m_][n_] = (f32x4){0.f, 0.f, 0.f, 0.f};
    }
    __device__ __forceinline__ void operator()(const f32x4 (&acc)[2][2][4][2], const Unit& u, int wr, int wc, int fr, int fq) const {
        const int pn = u.pn; size_t boff; int ldc, colt, act;
        if (pn < 2) { boff = P_U; ldc = GW; colt = pn * 256; act = 1; }
        else if (pn < 4) { boff = P_V; ldc = GW; colt = (pn - 2) * 256; act = 2; }
        else if (pn < 8) { boff = P_Q; ldc = DM; colt = (pn - 4) * 256; act = 3; }
        else if (pn < 12) { boff = P_F; ldc = DM; colt = (pn - 8) * 256; act = 0; }
        else if (pn < 16) { boff = P_I; ldc = DM; colt = (pn - 12) * 256; act = 0; }
        else if (pn < 20) { boff = P_ZO; ldc = DM; colt = (pn - 16) * 256; act = 3; }
        else if (pn < 24) { boff = P_GA; ldc = DM / 2; colt = (pn - 20) * 256; act = 4; }
        else { boff = P_GB; ldc = DM / 2; colt = (pn - 24) * 256; act = 4; }
        bf16_t* base = (bf16_t*)(P + boff);
        const int col0 = colt + wc * 32 + 8 * fq;
        f32x4 pr[2][4];
#pragma unroll
        for (int ai = 0; ai < 2; ++ai)
#pragma unroll
            for (int m = 0; m < 4; ++m) pr[ai][m] = *(const f32x4*)(ssp + (size_t)(u.pm * 256 + ai * 128 + wr * 64 + m * 16 + fr) * 4);
#pragma unroll
        for (int ai = 0; ai < 2; ++ai)
#pragma unroll
            for (int m = 0; m < 4; ++m) {
                const int row = u.pm * 256 + ai * 128 + wr * 64 + m * 16 + fr;
                const float rs = rstd4(pr[ai][m]);
                bf16_t* rowp = base + (size_t)row * ldc + col0;
                float s1 = 0.f, s2 = 0.f;
#pragma unroll
                for (int bj = 0; bj < 2; ++bj) {
                    f32x4 v0 = acc[ai][bj][m][0] * rs, v1 = acc[ai][bj][m][1] * rs;
                    if (act == 1 || act == 2) {
                        f32x2 a = gelu_pk((f32x2){v0[0], v0[1]}), b = gelu_pk((f32x2){v0[2], v0[3]}), c = gelu_pk((f32x2){v1[0], v1[1]}), d = gelu_pk((f32x2){v1[2], v1[3]});
                        v0 = (f32x4){a.x, a.y, b.x, b.y}; v1 = (f32x4){c.x, c.y, d.x, d.y};
                        if (act == 2) {
                            s1 += ((v0[0] + v0[1]) + (v0[2] + v0[3])) + ((v1[0] + v1[1]) + (v1[2] + v1[3]));
                            s2 += ((v0[0] * v0[0] + v0[1] * v0[1]) + (v0[2] * v0[2] + v0[3] * v0[3])) + ((v1[0] * v1[0] + v1[1] * v1[1]) + (v1[2] * v1[2] + v1[3] * v1[3]));
                        }
                    } else if (act == 3) {
#pragma unroll
                        for (int e = 0; e < 4; ++e) { v0[e] = siluf_(v0[e]); v1[e] = siluf_(v1[e]); }
                    } else if (act == 4) {
                        unsigned q0 = 0u, q1 = 0u;
#pragma unroll
                        for (int e = 0; e < 4; ++e) { q0 |= (unsigned)(sigmoidf_(v0[e]) * 255.0f + 0.5f) << (8 * e); q1 |= (unsigned)(sigmoidf_(v1[e]) * 255.0f + 0.5f) << (8 * e); }
                        *(u32x2*)((unsigned char*)base + (size_t)row * DM + col0 + bj * 128) = (u32x2){q0, q1};
                        continue;
                    }
                    u32x4 w; w.x = cvt_pk_bf16(v0[0], v0[1]); w.y = cvt_pk_bf16(v0[2], v0[3]); w.z = cvt_pk_bf16(v1[0], v1[1]); w.w = cvt_pk_bf16(v1[2], v1[3]);
                    *(u32x4*)(rowp + bj * 128) = w;
                }
                if (act == 2) {
                    s1 += __shfl_xor(s1, 16); s1 += __shfl_xor(s1, 32); s2 += __shfl_xor(s2, 16); s2 += __shfl_xor(s2, 32);
                    if (fq == 0) vst[(size_t)row * 8 + (pn - 2) * 4 + wc] = (f32x2){s1, s2};
                }
            }
    }
};
struct EpiMix {
    const unsigned char* G; bf16_t* MIX; int first;
    __device__ __forceinline__ void init(f32x4 (&acc)[2][2][4][2], const Unit&, int, int, int, int) const {
#pragma unroll
        for (int a_ = 0; a_ < 2; ++a_)
#pragma unroll
            for (int b_ = 0; b_ < 2; ++b_)
#pragma unroll
                for (int m_ = 0; m_ < 4; ++m_)
#pragma unroll
                    for (int n_ = 0; n_ < 2; ++n_) acc[a_][b_][m_][n_] = (f32x4){0.f, 0.f, 0.f, 0.f};
    }
    __device__ __forceinline__ void operator()(const f32x4 (&acc)[2][2][4][2], const Unit& u, int wr, int wc, int fr, int fq) const {
        const int col0 = u.pn * 256 + wc * 32 + 8 * fq;
        u32x2 gq[2][4][2];
#pragma unroll
        for (int ai = 0; ai < 2; ++ai)
#pragma unroll
            for (int m = 0; m < 4; ++m) {
                const size_t off = (size_t)(u.pm * 256 + ai * 128 + wr * 64 + m * 16 + fr) * DM + col0;
#pragma unroll
                for (int bj = 0; bj < 2; ++bj) gq[ai][m][bj] = *(const u32x2*)(G + off + bj * 128);
            }
#pragma unroll
        for (int ai = 0; ai < 2; ++ai) {
            u32x4 mq[1][4][2];
#pragma unroll
            for (int m = 0; m < 4; ++m) {
                const size_t off = (size_t)(u.pm * 256 + ai * 128 + wr * 64 + m * 16 + fr) * DM + col0;
#pragma unroll
                for (int bj = 0; bj < 2; ++bj) mq[0][m][bj] = first ? (u32x4){0u, 0u, 0u, 0u} : *(const u32x4*)(MIX + off + bj * 128);
            }
#pragma unroll
            for (int m = 0; m < 4; ++m) {
                const size_t off = (size_t)(u.pm * 256 + ai * 128 + wr * 64 + m * 16 + fr) * DM + col0;
#pragma unroll
                for (int bj = 0; bj < 2; ++bj) {
                    const u32x2 g2 = gq[ai][m][bj]; const u32x4 m4 = mq[0][m][bj];
                    constexpr float IG = 1.0f / 255.0f;
                    f32x4 v0 = acc[ai][bj][m][0], v1 = acc[ai][bj][m][1];
                    v0[0] = v0[0] * ((float)(g2.x & 255u) * IG) + bf2f(m4.x & 0xffffu); v0[1] = v0[1] * ((float)((g2.x >> 8) & 255u) * IG) + bf2f(m4.x >> 16);
                    v0[2] = v0[2] * ((float)((g2.x >> 16) & 255u) * IG) + bf2f(m4.y & 0xffffu); v0[3] = v0[3] * ((float)(g2.x >> 24) * IG) + bf2f(m4.y >> 16);
                    v1[0] = v1[0] * ((float)(g2.y & 255u) * IG) + bf2f(m4.z & 0xffffu); v1[1] = v1[1] * ((float)((g2.y >> 8) & 255u) * IG) + bf2f(m4.z >> 16);
                    v1[2] = v1[2] * ((float)((g2.y >> 16) & 255u) * IG) + bf2f(m4.w & 0xffffu); v1[3] = v1[3] * ((float)(g2.y >> 24) * IG) + bf2f(m4.w >> 16);
                    u32x4 w; w.x = cvt_pk_bf16(v0[0], v0[1]); w.y = cvt_pk_bf16(v0[2], v0[3]); w.z = cvt_pk_bf16(v1[0], v1[1]); w.w = cvt_pk_bf16(v1[2], v1[3]);
                    *(u32x4*)(MIX + off + bj * 128) = w;
                }
            }
        }
    }
};
struct EpiResid {
    bf16_t* XB; float* ssp; LAS unsigned char* red;
    __device__ __forceinline__ void init(f32x4 (&acc)[2][2][4][2], const Unit& u, int wr, int wc, int fr, int fq) const {
        const int col0 = u.pn * 256 + wc * 32 + 8 * fq;
#pragma unroll
        for (int ai = 0; ai < 2; ++ai)
#pragma unroll
            for (int m = 0; m < 4; ++m) {
                const size_t off = (size_t)(u.pm * 256 + ai * 128 + wr * 64 + m * 16 + fr) * DM + col0;
#pragma unroll
                for (int bj = 0; bj < 2; ++bj) {
                    const u32x4 q = *(const u32x4*)(XB + off + bj * 128);
                    acc[ai][bj][m][0] = (f32x4){bf2f(q.x & 0xffffu), bf2f(q.x >> 16), bf2f(q.y & 0xffffu), bf2f(q.y >> 16)};
                    acc[ai][bj][m][1] = (f32x4){bf2f(q.z & 0xffffu), bf2f(q.z >> 16), bf2f(q.w & 0xffffu), bf2f(q.w >> 16)};
                }
            }
    }
    __device__ __forceinline__ void operator()(const f32x4 (&acc)[2][2][4][2], const Unit& u, int wr, int wc, int fr, int fq) const {
        const int col0 = u.pn * 256 + wc * 32 + 8 * fq;
#pragma unroll
        for (int ai = 0; ai < 2; ++ai)
#pragma unroll
            for (int m = 0; m < 4; ++m) {
                const int rl = ai * 128 + wr * 64 + m * 16 + fr;
                const size_t off = (size_t)(u.pm * 256 + rl) * DM + col0;
                float ss = 0.f;
#pragma unroll
                for (int bj = 0; bj < 2; ++bj) {
                    const f32x4 v0 = acc[ai][bj][m][0], v1 = acc[ai][bj][m][1];
                    ss += ((v0[0] * v0[0] + v0[1] * v0[1]) + (v0[2] * v0[2] + v0[3] * v0[3])) + ((v1[0] * v1[0] + v1[1] * v1[1]) + (v1[2] * v1[2] + v1[3] * v1[3]));
                    u32x4 w; w.x = cvt_pk_bf16(v0[0], v0[1]); w.y = cvt_pk_bf16(v0[2], v0[3]); w.z = cvt_pk_bf16(v1[0], v1[1]); w.w = cvt_pk_bf16(v1[2], v1[3]);
                    *(u32x4*)(XB + off + bj * 128) = w;
                }
                ss += __shfl_xor(ss, 16); ss += __shfl_xor(ss, 32);
                if (fq == 0) *(LAS float*)(red + (rl * 4 + wc) * 4) = ss;
            }
        asm volatile("s_waitcnt lgkmcnt(0)" ::: "memory"); __builtin_amdgcn_s_barrier(); asm volatile("" ::: "memory");
        const int t = (wr * 4 + wc) * 64 + fq * 16 + fr;
        if (t < 256) { const f32x4 p = *(const LAS f32x4*)(red + t * 16); ssp[(size_t)(u.pm * 256 + t) * 4 + u.pn] = (p[0] + p[1]) + (p[2] + p[3]); }
    }
};
struct EpiFF1 {
    const float* ssp; bf16_t* H;
    __device__ __forceinline__ void init(f32x4 (&acc)[2][2][4][2], const Unit&, int, int, int, int) const {
#pragma unroll
        for (int a_ = 0; a_ < 2; ++a_)
#pragma unroll
            for (int b_ = 0; b_ < 2; ++b_)
#pragma unroll
                for (int m_ = 0; m_ < 4; ++m_)
#pragma unroll
                    for (int n_ = 0; n_ < 2; ++n_) acc[a_][b_][m_][n_] = (f32x4){0.f, 0.f, 0.f, 0.f};
    }
    __device__ __forceinline__ void operator()(const f32x4 (&acc)[2][2][4][2], const Unit& u, int wr, int wc, int fr, int fq) const {
        const int col0 = u.pn * 256 + wc * 32 + 8 * fq;
        f32x4 pr[2][4];
#pragma unroll
        for (int ai = 0; ai < 2; ++ai)
#pragma unroll
            for (int m = 0; m < 4; ++m) pr[ai][m] = *(const f32x4*)(ssp + (size_t)(u.pm * 256 + ai * 128 + wr * 64 + m * 16 + fr) * 4);
#pragma unroll
        for (int ai = 0; ai < 2; ++ai)
#pragma unroll
            for (int m = 0; m < 4; ++m) {
                const int row = u.pm * 256 + ai * 128 + wr * 64 + m * 16 + fr;
                const float rs = rstd4(pr[ai][m]);
                bf16_t* rowp = H + (size_t)row * DFF + col0;
#pragma unroll
                for (int bj = 0; bj < 2; ++bj) {
                    f32x4 v0 = acc[ai][bj][m][0], v1 = acc[ai][bj][m][1];
#pragma unroll
                    for (int e = 0; e < 4; ++e) { const float a = fmaxf(v0[e], 0.f), b = fmaxf(v1[e], 0.f); v0[e] = a * a; v1[e] = b * b; }
                    v0 = v0 * (rs * rs); v1 = v1 * (rs * rs);
                    u32x4 w; w.x = cvt_pk_bf16(v0[0], v0[1]); w.y = cvt_pk_bf16(v0[2], v0[3]); w.z = cvt_pk_bf16(v1[0], v1[1]); w.w = cvt_pk_bf16(v1[2], v1[3]);
                    *(u32x4*)(rowp + bj * 128) = w;
                }
            }
    }
};

constexpr int LDS_BYTES = 147456;

struct Args { const float* in[16]; float* out; unsigned char* ws; int lo, hi; };

struct P0Item { const float* W; bf16_t* WT; const float* gsc; int K, N, k0, n0; };
__device__ __forceinline__ P0Item p0_decode(const __attribute__((address_space(4))) Args* kp, int it, int l) {
    constexpr int T_IN = 448, T_A = 32, T_B = 64, T_O = 64, T_1 = 256, T_2 = 256, T_L = T_IN + T_A + T_B + T_O + T_1 + T_2;
    int r = it; unsigned char* wl = kp->ws + WS_W;
    P0Item p;
    if (r < T_IN) { p.W = kp->in[1] + (size_t)l * DM * INC; p.K = DM; p.N = INC; p.WT = (bf16_t*)(wl + WL_IN); p.gsc = kp->in[11] + l * DM; }
    else if ((r -= T_IN) < T_A) { p.W = kp->in[6] + (size_t)l * GW * DM; p.K = GW; p.N = DM; p.WT = (bf16_t*)(wl + WL_A); p.gsc = nullptr; }
    else if ((r -= T_A) < T_B) { p.W = kp->in[9] + (size_t)l * DM * DM; p.K = DM; p.N = DM; p.WT = (bf16_t*)(wl + WL_B); p.gsc = nullptr; }
    else if ((r -= T_B) < T_O) { p.W = kp->in[10] + (size_t)l * DM * DM; p.K = DM; p.N = DM; p.WT = (bf16_t*)(wl + WL_O); p.gsc = nullptr; }
    else if ((r -= T_O) < T_1) { p.W = kp->in[13] + (size_t)l * DM * DFF; p.K = DM; p.N = DFF; p.WT = (bf16_t*)(wl + WL_1); p.gsc = kp->in[12] + l * DM; }
    else { r -= T_1; p.W = kp->in[14] + (size_t)l * DFF * DM; p.K = DFF; p.N = DM; p.WT = (bf16_t*)(wl + WL_2); p.gsc = nullptr; }
    const int nblk = p.N / 256; p.k0 = 64 * (r / nblk); p.n0 = 256 * (r % nblk);
    return p;
}
constexpr int P0_NITEMS = 448 + 32 + 64 + 64 + 256 + 256;
__device__ __forceinline__ void p0_load(const P0Item& p, f32x4 (&v)[8], int wid, int lane) {
#pragma unroll
    for (int i = 0; i < 8; ++i) {
        const int kk = p.k0 + wid * 8 + i;
        f32x4 x = __builtin_nontemporal_load((const f32x4*)(p.W + (size_t)kk * p.N + p.n0 + lane * 4));
        if (p.gsc) x = x * p.gsc[kk];
        v[i] = x;
    }
}


__device__ __forceinline__ void p0_transpose_item(const float* W, int K, int N, bf16_t* WT, const float* gsc, LAS float* scr, int item, int lane) {
    const int nblk = N / 32, kb = item / nblk, nb = item % nblk, k0 = 64 * kb, n0 = 32 * nb;
#pragma unroll
    for (int i = 0; i < 32; ++i) { const int kk = 2 * i + (lane >> 5); float w = W[(size_t)(k0 + kk) * N + n0 + (lane & 31)]; if (gsc) w *= gsc[k0 + kk]; scr[kk * 33 + (lane & 31)] = w; }
    asm volatile("s_waitcnt lgkmcnt(0)" ::: "memory");
    const int c = lane & 7;
#pragma unroll
    for (int j = 0; j < 4; ++j) { const int n = (lane >> 3) + 8 * j; const LAS float* s = scr + (8 * c) * 33 + n;
        u32x4 o; o.x = cvt_pk_bf16(s[0 * 33], s[1 * 33]); o.y = cvt_pk_bf16(s[2 * 33], s[3 * 33]); o.z = cvt_pk_bf16(s[4 * 33], s[5 * 33]); o.w = cvt_pk_bf16(s[6 * 33], s[7 * 33]);
        *(u32x4*)(WT + (size_t)(n0 + n) * K + k0 + 8 * c) = o; }
    asm volatile("s_waitcnt lgkmcnt(0)" ::: "memory");
}


constexpr int GM_VZ0 = 73728, GM_VZ1 = 106496;
__device__ __forceinline__ void gmlp_dma(LAS unsigned char* L, const bf16_t* V, int R0, int g, int buf, int tid) {
    const int wu = __builtin_amdgcn_readfirstlane(tid >> 6), lane = tid & 63;
    const int base = buf ? GM_VZ1 : GM_VZ0;
#pragma unroll
    for (int i = 0; i < 4; ++i) {
        const int p = wu * 64 + i * 512 + lane, row = p >> 4, c8 = p & 15;
        __builtin_amdgcn_global_load_lds((const unsigned*)(V + (size_t)(R0 + row) * GW + g * 128 + c8 * 8), (LAS unsigned*)(L + base + (wu * 64 + i * 512) * 16), 16, 0, 0);
    }
}
__device__ __forceinline__ void gmlp_unit(LAS unsigned char* L, bf16_t* U, const bf16_t* V, const f32x2* vst, const float* Wg, const float* bsg,
                                          const float* lng, const float* lnb, int R0, int g, int tid, int buf, bool stage_w, bool has_next, int nR0, int ng_) {
    constexpr int VT = 0, WSo = 34816, MU = 69632, RSo = MU + 512;
    const int wid = tid >> 6, lane = tid & 63, fr = lane & 15, fq = lane >> 4;
    const int VZg = buf ? GM_VZ1 : GM_VZ0;
    const float gc = lng[g * 128 + (tid & 127)], bc = lnb[g * 128 + (tid & 127)], bsv = bsg[16 * wid + fr];
    if (tid < 128) {
        const f32x4* p = (const f32x4*)(vst + (size_t)(R0 + tid) * 8);
        const f32x4 a = p[0], b = p[1], c = p[2], d = p[3];
        const float s1 = (a[0] + a[2]) + (b[0] + b[2]) + (c[0] + c[2]) + (d[0] + d[2]);
        const float s2 = (a[1] + a[3]) + (b[1] + b[3]) + (c[1] + c[3]) + (d[1] + d[3]);
        const float mean = s1 * (1.0f / GW), var = fmaxf(s2 * (1.0f / GW) - mean * mean, 0.f);
        *(LAS float*)(L + MU + tid * 4) = mean; *(LAS float*)(L + RSo + tid * 4) = rsqrtf(var + EPS);
    }
    if (stage_w)
#pragma unroll
    for (int i = 0; i < 8; ++i) {
        const int p = tid + i * 512, q = p >> 5, p4 = (p & 31) * 4;
        f32x4 w = *(const f32x4*)(Wg + q * 128 + p4);
        if (q < 64 && p4 >= 64) w = (f32x4){0.f, 0.f, 0.f, 0.f};
        u32x2 o; o.x = cvt_pk_bf16(w[0], w[1]); o.y = cvt_pk_bf16(w[2], w[3]);
        *(LAS u32x2*)(L + WSo + q * 272 + p4 * 2) = o;
    }
    asm volatile("s_waitcnt vmcnt(0)" ::: "memory");
    __syncthreads();
    if (has_next) gmlp_dma(L, V, nR0, ng_, buf ^ 1, tid);
    u32x2 uq8[8];
#pragma unroll
    for (int ct = 0; ct < 8; ++ct) uq8[ct] = *(const u32x2*)(U + (size_t)(R0 + 16 * wid + fr) * GW + g * 128 + 16 * ct + 4 * fq);
    {
        const int c = tid & 127, pq = tid >> 7;
        unsigned short raw[32];
#pragma unroll
        for (int j = 0; j < 32; ++j) raw[j] = *(const LAS unsigned short*)(L + VZg + (32 * pq + j) * 256 + c * 2);
        unsigned pk[16];
#pragma unroll
        for (int j = 0; j < 32; j += 2) {
            const int p0 = 32 * pq + j;
            const float m0 = *(LAS float*)(L + MU + p0 * 4), r0 = *(LAS float*)(L + RSo + p0 * 4), m1 = *(LAS float*)(L + MU + p0 * 4 + 4), r1 = *(LAS float*)(L + RSo + p0 * 4 + 4);
            const float y0 = (bf2f(raw[j]) - m0) * r0 * gc + bc, y1 = (bf2f(raw[j + 1]) - m1) * r1 * gc + bc;
            pk[j >> 1] = cvt_pk_bf16(y0, y1);
        }
#pragma unroll
        for (int j = 0; j < 4; ++j) *(LAS u32x4*)(L + VT + c * 272 + pq * 64 + j * 16) = (u32x4){pk[4 * j], pk[4 * j + 1], pk[4 * j + 2], pk[4 * j + 3]};
    }
    __syncthreads();
    {
        bf16x8 yb[4];
#pragma unroll
        for (int ks = 0; ks < 4; ++ks) yb[ks] = *(const LAS bf16x8*)(L + WSo + (16 * wid + fr) * 272 + (ks * 32 + fq * 8) * 2);
        const int q = 16 * wid + fr;
#pragma unroll
        for (int ct = 0; ct < 8; ++ct) {
            f32x4 acc = (f32x4){0.f, 0.f, 0.f, 0.f};
#pragma unroll
            for (int ks = 0; ks < 4; ++ks) {
                const bf16x8 xa = *(const LAS bf16x8*)(L + VT + (16 * ct + fr) * 272 + (ks * 32 + fq * 8) * 2);
                acc = __builtin_amdgcn_mfma_f32_16x16x32_bf16(xa, yb[ks], acc, 0, 0, 0);
            }
            bf16_t* up = U + (size_t)(R0 + q) * GW + g * 128 + 16 * ct + 4 * fq;
            const u32x2 uq = uq8[ct];
            u32x2 o;
            o.x = cvt_pk_bf16(bf2f(uq.x & 0xffffu) * (acc[0] + bsv), bf2f(uq.x >> 16) * (acc[1] + bsv));
            o.y = cvt_pk_bf16(bf2f(uq.y & 0xffffu) * (acc[2] + bsv), bf2f(uq.y >> 16) * (acc[3] + bsv));
            *(u32x2*)up = o;
        }
    }
    __syncthreads();
}

constexpr int B1_FZ = 40960, B1_VZ = 57344;
__device__ __forceinline__ void hgrn_b1_dma(LAS unsigned char* L, const bf16_t* Fg, const bf16_t* Vg, int tid) {
    const int wid = __builtin_amdgcn_readfirstlane(tid >> 6), lane = tid & 63;
#pragma unroll
    for (int i = 0; i < 2; ++i) {
        const int p = wid * 64 + i * 512 + lane, row = p >> 4, c8 = p & 15;
        __builtin_amdgcn_global_load_lds((const unsigned*)(Fg + (size_t)row * DM + c8 * 8), (LAS unsigned*)(L + B1_FZ + (wid * 64 + i * 512) * 16), 16, 0, 0);
        __builtin_amdgcn_global_load_lds((const unsigned*)(Vg + (size_t)row * DM + c8 * 8), (LAS unsigned*)(L + B1_VZ + (wid * 64 + i * 512) * 16), 16, 0, 0);
    }
}
__device__ __forceinline__ void hgrn_b1_unit(LAS unsigned char* L, bf16_t* Sout, float* Dout, float (&sst)[8][4], float& cumdec, const float lb, int tid, bool has_next, const bf16_t* nFg, const bf16_t* nVg) {
    constexpr int KET = 0, VT = 18432, TS = 36864;
    const int wid = tid >> 6, lane = tid & 63, fr = lane & 15, fq = lane >> 4;
    const int k = tid & 127, J = tid >> 7;
    unsigned short zf[16], zv[16];
#pragma unroll
    for (int j = 0; j < 16; ++j) { zv[j] = *(const LAS unsigned short*)(L + B1_VZ + (16 * J + j) * 256 + k * 2); zf[j] = *(const LAS unsigned short*)(L + B1_FZ + (16 * J + j) * 256 + k * 2); }
    const float oml = 1.0f - lb;
    float E[16], kk[16]; float run = 1.f;
#pragma unroll
    for (int j = 0; j < 16; ++j) {
        const float z = bf2f(zf[j]), e = __expf(-z), sig = fast_rcp(1.0f + e), f = lb + oml * sig;
        kk[j] = oml * e * sig; run *= f; E[j] = run;
    }
    *(LAS float*)(L + TS + (J * 128 + k) * 4) = run;
#pragma unroll
    for (int j = 0; j < 2; ++j) {
        u32x4 w; w.x = zv[8 * j] | ((unsigned)zv[8 * j + 1] << 16); w.y = zv[8 * j + 2] | ((unsigned)zv[8 * j + 3] << 16); w.z = zv[8 * j + 4] | ((unsigned)zv[8 * j + 5] << 16); w.w = zv[8 * j + 6] | ((unsigned)zv[8 * j + 7] << 16);
        *(LAS u32x4*)(L + VT + k * 144 + J * 32 + j * 16) = w;
    }
    __syncthreads();
    if (has_next) hgrn_b1_dma(L, nFg, nVg, tid);
    const float t0 = *(LAS float*)(L + TS + k * 4), t1 = *(LAS float*)(L + TS + (128 + k) * 4), t2 = *(LAS float*)(L + TS + (256 + k) * 4), t3 = *(LAS float*)(L + TS + (384 + k) * 4);
    const float tail = (J < 1 ? t1 : 1.f) * (J < 2 ? t2 : 1.f) * (J < 3 ? t3 : 1.f);
    {
        const float rt = run * tail;
        unsigned pk[8];
#pragma unroll
        for (int j = 0; j < 16; j += 2) pk[j >> 1] = cvt_pk_bf16(kk[j] * fast_rcp(fmaxf(E[j], 1e-30f)) * rt, kk[j + 1] * fast_rcp(fmaxf(E[j + 1], 1e-30f)) * rt);
        *(LAS u32x4*)(L + KET + k * 144 + J * 32) = (u32x4){pk[0], pk[1], pk[2], pk[3]};
        *(LAS u32x4*)(L + KET + k * 144 + J * 32 + 16) = (u32x4){pk[4], pk[5], pk[6], pk[7]};
    }
    if (J == 0) { Dout[k] = cumdec; cumdec *= (t0 * t1) * (t2 * t3); }
    __syncthreads();
    {
        bf16x8 xa[2];
#pragma unroll
        for (int ks = 0; ks < 2; ++ks) xa[ks] = *(const LAS bf16x8*)(L + KET + (16 * wid + fr) * 144 + (ks * 32 + fq * 8) * 2);
        f32x4 dk = *(const LAS f32x4*)(L + TS + (16 * wid + 4 * fq) * 4);
        dk = dk * *(const LAS f32x4*)(L + TS + (128 + 16 * wid + 4 * fq) * 4); dk = dk * *(const LAS f32x4*)(L + TS + (256 + 16 * wid + 4 * fq) * 4); dk = dk * *(const LAS f32x4*)(L + TS + (384 + 16 * wid + 4 * fq) * 4);
#pragma unroll
        for (int vt = 0; vt < 8; ++vt) {
            f32x4 acc = (f32x4){0.f, 0.f, 0.f, 0.f};
#pragma unroll
            for (int ks = 0; ks < 2; ++ks) {
                const bf16x8 yb = *(const LAS bf16x8*)(L + VT + (16 * vt + fr) * 144 + (ks * 32 + fq * 8) * 2);
                acc = __builtin_amdgcn_mfma_f32_16x16x32_bf16(xa[ks], yb, acc, 0, 0, 0);
            }
            u32x2 o; o.x = cvt_pk_bf16(sst[vt][0], sst[vt][1]); o.y = cvt_pk_bf16(sst[vt][2], sst[vt][3]);
            *(u32x2*)(Sout + (size_t)(16 * vt + fr) * 128 + 16 * wid + 4 * fq) = o;
#pragma unroll
            for (int i = 0; i < 4; ++i) sst[vt][i] = dk[i] * sst[vt][i] + acc[i];
        }
    }
    asm volatile("s_waitcnt vmcnt(0)" ::: "memory");
    __syncthreads();
}

constexpr int B3_FZ = 107008, B3_QZ = 123392, B3_VZ = 86528;
__device__ __forceinline__ void hgrn_b3_dma_v(LAS unsigned char* L, const bf16_t* Vg, int tid) {
    const int wid = __builtin_amdgcn_readfirstlane(tid >> 6), lane = tid & 63;
#pragma unroll
    for (int i = 0; i < 2; ++i) {
        const int p = wid * 64 + i * 512 + lane, row = p >> 4, c8 = p & 15;
        __builtin_amdgcn_global_load_lds((const unsigned*)(Vg + (size_t)row * DM + c8 * 8), (LAS unsigned*)(L + B3_VZ + (wid * 64 + i * 512) * 16), 16, 0, 0);
    }
}
__device__ __forceinline__ void hgrn_b3_dma(LAS unsigned char* L, const bf16_t* Qg, const bf16_t* Fg, int tid) {
    const int wid = __builtin_amdgcn_readfirstlane(tid >> 6), lane = tid & 63;
#pragma unroll
    for (int i = 0; i < 2; ++i) {
        const int p = wid * 64 + i * 512 + lane, row = p >> 4, c8 = p & 15;
        __builtin_amdgcn_global_load_lds((const unsigned*)(Fg + (size_t)row * DM + c8 * 8), (LAS unsigned*)(L + B3_FZ + (wid * 64 + i * 512) * 16), 16, 0, 0);
        __builtin_amdgcn_global_load_lds((const unsigned*)(Qg + (size_t)row * DM + c8 * 8), (LAS unsigned*)(L + B3_QZ + (wid * 64 + i * 512) * 16), 16, 0, 0);
    }
}
__device__ __forceinline__ void hgrn_b3_unit(LAS unsigned char* L, bf16_t* Vg, const bf16_t* ZOg, const bf16_t* Sin, const f32x4 (&sq0)[4], const f32x4 (&sq1)[4], const float* Dc,
                                             const float lb, const float* ng, int tid, bool has_next, const bf16_t* nQg, const bf16_t* nFg, const bf16_t* nVg) {
    constexpr int QE = 0, QP = 25600, KP = 43008, VT = 86528, TS = 104960, OO = KP;
    const int wid = tid >> 6, lane = tid & 63, fr = lane & 15, fq = lane >> 4;
    bf16x8 ybS[4];
    bf16x8 pfq[4]; f32x4 dq0[4], dq1[4];
#pragma unroll
    for (int ks = 0; ks < 4; ++ks) {
        pfq[ks] = *(const bf16x8*)(Sin + (size_t)(16 * wid + fr) * 128 + ks * 32 + fq * 8);
        dq0[ks] = *(const f32x4*)(Dc + ks * 32 + fq * 8); dq1[ks] = *(const f32x4*)(Dc + ks * 32 + fq * 8 + 4);
    }
    const int te = tid >> 3, v0e = (tid & 7) * 16;
    const u32x4 z0 = *(const u32x4*)(ZOg + (size_t)te * DM + v0e), z1 = *(const u32x4*)(ZOg + (size_t)te * DM + v0e + 8);
    {
        const int k = tid & 127, J = tid >> 7;
        unsigned short zv[16], zf[16], zq[16];
#pragma unroll
        for (int j = 0; j < 16; ++j) zv[j] = *(const LAS unsigned short*)(L + B3_VZ + (16 * J + j) * 256 + k * 2);
#pragma unroll
        for (int j = 0; j < 16; ++j) { zf[j] = *(const LAS unsigned short*)(L + B3_FZ + (16 * J + j) * 256 + k * 2); zq[j] = *(const LAS unsigned short*)(L + B3_QZ + (16 * J + j) * 256 + k * 2); }
        const float oml = 1.0f - lb;
        float E[16], kk[16], qp[16]; float run = 1.f;
#pragma unroll
        for (int j = 0; j < 16; ++j) {
            const float z = bf2f(zf[j]), e = __expf(-z), sig = fast_rcp(1.0f + e), f = lb + oml * sig;
            kk[j] = oml * e * sig; run *= f; E[j] = run;
            qp[j] = bf2f(zq[j]) * run;
            *(LAS unsigned short*)(L + QP + (16 * J + j) * 272 + k * 2) = (unsigned short)(cvt_pk_bf16(qp[j], 0.f) & 0xffffu);
        }
        *(LAS float*)(L + TS + (J * 128 + k) * 4) = run;
        __syncthreads();
        if (has_next) hgrn_b3_dma(L, nQg, nFg, tid);
#pragma unroll
        for (int ks = 0; ks < 4; ++ks) {
            float v[8];
#pragma unroll
            for (int e = 0; e < 4; ++e) { v[e] = bf2f((unsigned)(unsigned short)pfq[ks][e]) + dq0[ks][e] * sq0[ks][e]; v[4 + e] = bf2f((unsigned)(unsigned short)pfq[ks][4 + e]) + dq1[ks][e] * sq1[ks][e]; }
            const u32x4 w = (u32x4){cvt_pk_bf16(v[0], v[1]), cvt_pk_bf16(v[2], v[3]), cvt_pk_bf16(v[4], v[5]), cvt_pk_bf16(v[6], v[7])};
            ybS[ks] = __builtin_bit_cast(bf16x8, w);
        }
#pragma unroll
        for (int j = 0; j < 2; ++j) {
            u32x4 w; w.x = zv[8 * j] | ((unsigned)zv[8 * j + 1] << 16); w.y = zv[8 * j + 2] | ((unsigned)zv[8 * j + 3] << 16); w.z = zv[8 * j + 4] | ((unsigned)zv[8 * j + 5] << 16); w.w = zv[8 * j + 6] | ((unsigned)zv[8 * j + 7] << 16);
            *(LAS u32x4*)(L + VT + k * 144 + J * 32 + j * 16) = w;
        }
        const float t0 = *(LAS float*)(L + TS + k * 4), t1 = *(LAS float*)(L + TS + (128 + k) * 4), t2 = *(LAS float*)(L + TS + (256 + k) * 4);
        const float r1 = t0, r2 = t0 * t1, r3 = r2 * t2;
        const float erj = J == 0 ? 1.f : (J == 1 ? r1 : (J == 2 ? r2 : r3));
#pragma unroll
        for (int j = 0; j < 16; ++j) *(LAS unsigned short*)(L + QE + (16 * J + j) * 400 + k * 2) = (unsigned short)(cvt_pk_bf16(qp[j] * erj, 0.f) & 0xffffu);
        {
            float kd[16], ke[16];
#pragma unroll
            for (int j = 0; j < 16; ++j) { kd[j] = kk[j] * fast_rcp(fmaxf(E[j], 1e-30f)); ke[j] = kd[j] * run; }
            const float tA = J == 0 ? t1 : t2, tB = t2;
#pragma unroll
            for (int I = 0; I < 4; ++I) {
                if (I >= J) {
                    const float gI = (I - J <= 1) ? 1.f : ((I - J == 2) ? tA : tA * tB);
                    const int base = (I == 0 ? 0 : (I == 1 ? 16 : (I == 2 ? 48 : 96))) + 16 * J;
#pragma unroll
                    for (int j = 0; j < 16; ++j) {
                        const float v = (I == J) ? kd[j] : ke[j] * gI;
                        *(LAS unsigned short*)(L + KP + (base + j) * 272 + k * 2) = (unsigned short)(cvt_pk_bf16(v, 0.f) & 0xffffu);
                    }
                }
            }
        }
    }
    __syncthreads();
#pragma unroll
    for (int rep = 0; rep < 2; ++rep) {
        const int idx = wid + 8 * rep, I = idx >> 2, Jt = idx & 3;
        u32x2 o = (u32x2){0u, 0u};
        if (Jt <= I) {
            const int base = (I == 0 ? 0 : (I == 1 ? 16 : (I == 2 ? 48 : 96))) + 16 * Jt;
            f32x4 acc = (f32x4){0.f, 0.f, 0.f, 0.f};
#pragma unroll
            for (int ks = 0; ks < 4; ++ks) {
                const bf16x8 xa = *(const LAS bf16x8*)(L + KP + (base + fr) * 272 + (ks * 32 + fq * 8) * 2);
                const bf16x8 yb = *(const LAS bf16x8*)(L + QP + (16 * I + fr) * 272 + (ks * 32 + fq * 8) * 2);
                acc = __builtin_amdgcn_mfma_f32_16x16x32_bf16(xa, yb, acc, 0, 0, 0);
            }
            if (Jt == I) {
#pragma unroll
                for (int i = 0; i < 4; ++i) if (4 * fq + i > fr) acc[i] = 0.f;
            }
            o.x = cvt_pk_bf16(acc[0], acc[1]); o.y = cvt_pk_bf16(acc[2], acc[3]);
        }
        *(LAS u32x2*)(L + QE + (16 * I + fr) * 400 + (128 + 16 * Jt + 4 * fq) * 2) = o;
    }
    __syncthreads();
    const f32x4 g0 = *(const f32x4*)(ng + v0e), g1 = *(const f32x4*)(ng + v0e + 4), g2 = *(const f32x4*)(ng + v0e + 8), g3 = *(const f32x4*)(ng + v0e + 12);
    {
        bf16x8 yb[6];
#pragma unroll
        for (int ks = 0; ks < 4; ++ks) yb[ks] = ybS[ks];
#pragma unroll
        for (int ks = 0; ks < 2; ++ks) yb[4 + ks] = *(const LAS bf16x8*)(L + VT + (16 * wid + fr) * 144 + (ks * 32 + fq * 8) * 2);
        f32x4 acc[4];
#pragma unroll
        for (int I = 0; I < 4; ++I) {
            acc[I] = (f32x4){0.f, 0.f, 0.f, 0.f};
#pragma unroll
            for (int ks = 0; ks < 6; ++ks) {
                const bf16x8 xa = *(const LAS bf16x8*)(L + QE + (16 * I + fr) * 400 + (ks * 32 + fq * 8) * 2);
                acc[I] = __builtin_amdgcn_mfma_f32_16x16x32_bf16(xa, yb[ks], acc[I], 0, 0, 0);
            }
        }
#pragma unroll
        for (int I = 0; I < 4; ++I)
#pragma unroll
            for (int i = 0; i < 4; ++i) *(LAS float*)(L + OO + (16 * I + 4 * fq + i) * 528 + (16 * wid + fr) * 4) = acc[I][i];
    }
    __syncthreads();
    if (has_next) hgrn_b3_dma_v(L, nVg, tid);
    {
        const int t = te, v0 = v0e;
        f32x4 ov[4]; float ss = 0.f;
#pragma unroll
        for (int j = 0; j < 4; ++j) { ov[j] = *(const LAS f32x4*)(L + OO + t * 528 + (v0 + 4 * j) * 4); ss += (ov[j][0] * ov[j][0] + ov[j][1] * ov[j][1]) + (ov[j][2] * ov[j][2] + ov[j][3] * ov[j][3]); }
        ss += __shfl_xor(ss, 1); ss += __shfl_xor(ss, 2); ss += __shfl_xor(ss, 4);
        const float rstd = rsqrtf(ss * (1.0f / 128.0f) + EPS);
        u32x4 w0, w1;
        w0.x = cvt_pk_bf16(ov[0][0] * rstd * g0[0] * bf2f(z0.x & 0xffffu), ov[0][1] * rstd * g0[1] * bf2f(z0.x >> 16));
        w0.y = cvt_pk_bf16(ov[0][2] * rstd * g0[2] * bf2f(z0.y & 0xffffu), ov[0][3] * rstd * g0[3] * bf2f(z0.y >> 16));
        w0.z = cvt_pk_bf16(ov[1][0] * rstd * g1[0] * bf2f(z0.z & 0xffffu), ov[1][1] * rstd * g1[1] * bf2f(z0.z >> 16));
        w0.w = cvt_pk_bf16(ov[1][2] * rstd * g1[2] * bf2f(z0.w & 0xffffu), ov[1][3] * rstd * g1[3] * bf2f(z0.w >> 16));
        w1.x = cvt_pk_bf16(ov[2][0] * rstd * g2[0] * bf2f(z1.x & 0xffffu), ov[2][1] * rstd * g2[1] * bf2f(z1.x >> 16));
        w1.y = cvt_pk_bf16(ov[2][2] * rstd * g2[2] * bf2f(z1.y & 0xffffu), ov[2][3] * rstd * g2[3] * bf2f(z1.y >> 16));
        w1.z = cvt_pk_bf16(ov[3][0] * rstd * g3[0] * bf2f(z1.z & 0xffffu), ov[3][1] * rstd * g3[1] * bf2f(z1.z >> 16));
        w1.w = cvt_pk_bf16(ov[3][2] * rstd * g3[2] * bf2f(z1.w & 0xffffu), ov[3][3] * rstd * g3[3] * bf2f(z1.w >> 16));
        *(u32x4*)(Vg + (size_t)t * DM + v0) = w0; *(u32x4*)(Vg + (size_t)t * DM + v0 + 8) = w1;
    }
    asm volatile("s_waitcnt vmcnt(0)" ::: "memory");
    __syncthreads();
}


#define XB_TMO      128
#define XB_XCNT(j)  (256  + 64 * (j))
#define XB_XSUB(j)  (1280 + 64 * (j))
#define XB_XGEN(j)  (2304 + 64 * (j))
#define XB_TOP      3328
#define XB_TOPGEN   3392
#define XCD_BAR_WORDS 3456
#define XB_SPIN_CAP (1u << 22)
__device__ __forceinline__ unsigned xb_ld(unsigned* p)              { return __hip_atomic_load(p, __ATOMIC_RELAXED, __HIP_MEMORY_SCOPE_AGENT); }
__device__ __forceinline__ unsigned xb_add(unsigned* p, unsigned v) { return __hip_atomic_fetch_add(p, v, __ATOMIC_RELAXED, __HIP_MEMORY_SCOPE_AGENT); }
__device__ __forceinline__ unsigned xb_xcc_id() { return (unsigned)__builtin_amdgcn_s_getreg((3 << 11) | 20) & 0xFu; }
#define XB_SPIN(cond, bar) do { unsigned _sp = 0; while (cond) { __builtin_amdgcn_s_sleep(1); \
    if ((++_sp & 255u) == 0u) { if (xb_ld(&(bar)[XB_TMO])) break; if (_sp > XB_SPIN_CAP) { atomicAdd(&(bar)[XB_TMO], 1u); break; } } } } while (0)
struct XcdBarrier { unsigned* bar; unsigned x; volatile LAS unsigned* st; };
__device__ __forceinline__ XcdBarrier xcd_barrier_post(unsigned* bar, volatile LAS unsigned* st) {
    XcdBarrier b; b.bar = bar; b.x = xb_xcc_id(); b.st = st;
    if (threadIdx.x == 0) (void)xb_add(&bar[XB_XCNT(b.x)], 1u);
    return b;
}
__device__ __forceinline__ void xcd_barrier_complete(unsigned* bar, unsigned x, unsigned& nloc, unsigned& nx) {
    const unsigned G = gridDim.x * gridDim.y * gridDim.z;
    unsigned sum, cnt, mine, sp = 0u;
    for (;;) {
        sum = 0u; cnt = 0u; mine = 0u;
#pragma unroll
        for (unsigned j = 0; j < 16; ++j) { const unsigned c = xb_ld(&bar[XB_XCNT(j)]); sum += c; cnt += (c > 0u) ? 1u : 0u; mine = (j == x) ? c : mine; }
        if (sum == G) break;
        __builtin_amdgcn_s_sleep(1);
        if ((++sp & 255u) == 0u) { if (xb_ld(&bar[XB_TMO])) break; if (sp > XB_SPIN_CAP) { atomicAdd(&bar[XB_TMO], 1u); break; } }
    }
    nloc = mine > 0u ? mine : 1u; nx = cnt > 0u ? cnt : 1u;
}
__device__ __forceinline__ void xcd_barrier(const XcdBarrier& b) {
    asm volatile("s_waitcnt vmcnt(0)" ::: "memory");
    __syncthreads();
    if (threadIdx.x == 0) {
        unsigned* bar = b.bar;
        __builtin_amdgcn_s_waitcnt(0);
        unsigned nloc = b.st[0], nx = b.st[1];
        if (nloc == 0u) { xcd_barrier_complete(bar, b.x, nloc, nx); b.st[0] = nloc; b.st[1] = nx; }
        const unsigned old = xb_add(&bar[XB_XSUB(b.x)], 1u);
        const unsigned gen = old / nloc;
        if (old + 1u == (gen + 1u) * nloc) {
            __builtin_amdgcn_fence(__ATOMIC_RELEASE, "agent");
            asm volatile("s_waitcnt vmcnt(0)" ::: "memory");
            const unsigned og = xb_add(&bar[XB_TOP], 1u);
            const unsigned tg = og / nx;
            if (og + 1u == (tg + 1u) * nx) xb_add(&bar[XB_TOPGEN], 1u);
            else XB_SPIN(xb_ld(&bar[XB_TOPGEN]) == tg, bar);
            __builtin_amdgcn_fence(__ATOMIC_ACQUIRE, "agent");
            xb_add(&bar[XB_XGEN(b.x)], 1u);
            asm volatile("s_waitcnt vmcnt(0)" ::: "memory");
        } else {
            XB_SPIN(xb_ld(&bar[XB_XGEN(b.x)]) == gen, bar);
            __builtin_amdgcn_fence(__ATOMIC_ACQUIRE, "agent");
            asm volatile("s_waitcnt vmcnt(0)" ::: "memory");
        }
    }
    __syncthreads();
}
constexpr size_t WS_BAR = 65536;

__global__ void __launch_bounds__(512, 2) mega_fwd(Args a) {
    unsigned char* ap_ws = a.ws;
    __shared__ __attribute__((aligned(16))) unsigned char lds_raw[LDS_BYTES];
    LAS unsigned char* L = (LAS unsigned char*)lds_raw;
    cg::grid_group grid = cg::this_grid();
    volatile LAS unsigned* bst = (volatile LAS unsigned*)(L + LDS_BYTES - 16);
    if (threadIdx.x < 2) bst[threadIdx.x] = 0u;
    __syncthreads();
    (void)xcd_barrier_post((unsigned*)(ap_ws + WS_BAR), bst);
    const int st_hi = a.hi;
    for (int st = a.lo; st < st_hi; ++st) {
        const __attribute__((address_space(4))) Args* kp = (const __attribute__((address_space(4))) Args*)__builtin_amdgcn_kernarg_segment_ptr();
        asm volatile("" : "+s"(kp));
        if (st != 0 && st != 9 && st != 18 && (st - 1 - (st > 9 ? 9 : 0)) == 2) continue;
#define a (*kp)
        int tid = threadIdx.x; asm volatile("" : "+v"(tid));
        int bx = blockIdx.x; asm volatile("" : "+s"(bx));
        int G = gridDim.x; asm volatile("" : "+s"(G));
        const int lane = tid & 63, wave = __builtin_amdgcn_readfirstlane(tid >> 6);
        unsigned char* ws = a.ws;
        const float* x_in = a.in[0];
        float* lbv = (float*)(ws + WS_LBV);
        bf16_t* XB = (bf16_t*)(ws + WS_XB); float* SSP = (float*)(ws + WS_SSP);
        unsigned char* P = ws + WS_P;
        bf16_t *bU = (bf16_t*)(P + P_U), *bV = (bf16_t*)(P + P_V), *bQ = (bf16_t*)(P + P_Q), *bF = (bf16_t*)(P + P_F), *bI = (bf16_t*)(P + P_I), *bZO = (bf16_t*)(P + P_ZO),
               *bS = (bf16_t*)a.out  , *MIX = bQ  ;
        const unsigned char *bGA = P + P_GA, *bGB = P + P_GB;
        f32x2* bVST = (f32x2*)(P + P_VST); float* bD = (float*)(P + P_D);
        bf16_t* H1 = (bf16_t*)(ws + WS_H1);
        if (st >= 100) {
#ifdef DBG_OFF
            const bf16_t* src = (const bf16_t*)(ws + (size_t)DBG_OFF);
            for (size_t i = (size_t)bx * 512 + tid; i < (size_t)MTOT * DM; i += (size_t)G * 512) a.out[i] = bf2f(src[i]);
#endif
        } else if (st == 0 || st == 9) {
            const int wlayer = st == 0 ? 0 : 1;
            const int gw = bx * 8 + wave, NGW = G * 8;
            {
                LAS float* T = (LAS float*)L;
                f32x4 v[8];
                int it = bx;
                { const P0Item p = p0_decode(kp, it < P0_NITEMS ? it : P0_NITEMS - 1, wlayer); p0_load(p, v, wave, lane); }
                while (it < P0_NITEMS) {
                    const P0Item p = p0_decode(kp, it, wlayer);
#pragma unroll
                    for (int i = 0; i < 8; ++i)
#pragma unroll
                        for (int e = 0; e < 4; ++e) T[(wave * 8 + i) * 257 + lane * 4 + e] = v[i][e];
                    __syncthreads();
                    const int nx = it + G;
                    if (nx < P0_NITEMS) { const P0Item q = p0_decode(kp, nx, wlayer); p0_load(q, v, wave, lane); }
#pragma unroll
                    for (int j = 0; j < 4; ++j) {
                        const int q = tid + j * 512, n = q >> 3, c = q & 7;
                        const LAS float* t = T + (8 * c) * 257 + n;
                        u32x4 o; o.x = cvt_pk_bf16(t[0], t[257]); o.y = cvt_pk_bf16(t[2 * 257], t[3 * 257]); o.z = cvt_pk_bf16(t[4 * 257], t[5 * 257]); o.w = cvt_pk_bf16(t[6 * 257], t[7 * 257]);
                        *(u32x4*)(p.WT + (size_t)(p.n0 + n) * p.K + p.k0 + 8 * c) = o;
                    }
                    __syncthreads();
                    it = nx;
                }
            }
            const int m_end = st == 0 ? MTOT : 0;
            for (int m = gw; m < m_end; m += 2 * NGW) {
                const int m2 = m + NGW;
                const f32x4* xr = (const f32x4*)(x_in + (size_t)m * DM) + lane;
                const f32x4* xr2 = (const f32x4*)(x_in + (size_t)(m2 < MTOT ? m2 : m) * DM) + lane;
                f32x4 v[4], w[4]; float s = 0.f, s2 = 0.f;
#pragma unroll
                for (int j = 0; j < 4; ++j) { v[j] = __builtin_nontemporal_load(&xr[64 * j]); w[j] = __builtin_nontemporal_load(&xr2[64 * j]); }
#pragma unroll
                for (int j = 0; j < 4; ++j) { s += (v[j][0] * v[j][0] + v[j][1] * v[j][1]) + (v[j][2] * v[j][2] + v[j][3] * v[j][3]); s2 += (w[j][0] * w[j][0] + w[j][1] * w[j][1]) + (w[j][2] * w[j][2] + w[j][3] * w[j][3]); }
                s = wave_sum(s); s2 = wave_sum(s2);
                u32x2* o8 = (u32x2*)(XB + (size_t)m * DM) + lane;
#pragma unroll
                for (int j = 0; j < 4; ++j) o8[64 * j] = (u32x2){cvt_pk_bf16(v[j][0], v[j][1]), cvt_pk_bf16(v[j][2], v[j][3])};
                if (lane == 0) *(f32x4*)(SSP + (size_t)m * 4) = (f32x4){s, 0.f, 0.f, 0.f};
                if (m2 < MTOT) {
                    u32x2* o9 = (u32x2*)(XB + (size_t)m2 * DM) + lane;
#pragma unroll
                    for (int j = 0; j < 4; ++j) o9[64 * j] = (u32x2){cvt_pk_bf16(w[j][0], w[j][1]), cvt_pk_bf16(w[j][2], w[j][3])};
                    if (lane == 0) *(f32x4*)(SSP + (size_t)m2 * 4) = (f32x4){s2, 0.f, 0.f, 0.f};
                }
            }
            for (int i = bx * 512 + tid; i < (st == 0 ? 2048 : 0); i += G * 512) {
                const int c = i & 1023;
                lbv[i] = (i < 1024) ? 0.f : fast_rcp(1.0f + __expf(a.in[7][c] - a.in[7][1024 + c]));
            }
        } else if (st == 18) {
            const int gw = bx * 8 + wave, NGW = G * 8;
            const float* fn = a.in[15];
            f32x4 gq[4];
#pragma unroll
            for (int j = 0; j < 4; ++j) gq[j] = *((const f32x4*)fn + 64 * j + lane);
            for (int m0 = gw; m0 < MTOT; m0 += 4 * NGW) {
                u32x2 xv[4][4]; f32x4 pp[4];
#pragma unroll
                for (int r = 0; r < 4; ++r) {
                    const int m = m0 + r * NGW < MTOT ? m0 + r * NGW : m0;
                    const u32x2* xr = (const u32x2*)(XB + (size_t)m * DM) + lane;
#pragma unroll
                    for (int j = 0; j < 4; ++j) xv[r][j] = __builtin_nontemporal_load(&xr[64 * j]);
                    pp[r] = *(const f32x4*)(SSP + (size_t)m * 4);
                }
#pragma unroll
                for (int r = 0; r < 4; ++r) {
                    const int m = m0 + r * NGW;
                    if (m < MTOT) {
                        const float rstd = rstd4(pp[r]);
                        f32x4* orow = (f32x4*)(a.out + (size_t)m * DM) + lane;
#pragma unroll
                        for (int j = 0; j < 4; ++j) {
                            const f32x4 v = (f32x4){bf2f(xv[r][j].x & 0xffffu), bf2f(xv[r][j].x >> 16), bf2f(xv[r][j].y & 0xffffu), bf2f(xv[r][j].y >> 16)};
                            __builtin_nontemporal_store(v * rstd * gq[j], &orow[64 * j]);
                        }
                    }
                }
            }
        } else {
            const int l = st > 9 ? 1 : 0, k = st - 1 - 9 * l;
            unsigned char* wl = ws + WS_W;
            if (k < 5) {
                const int kind = k;
                if (kind == 0) {
                    pg8::Gemm g{XB, (const bf16_t*)(wl + WL_IN), MTOT, INC, DM};
                    pg8::StaticOrder S; S.init(MTOT, INC, G, bx);
                    EpiInProj E{SSP, P, bVST};

#ifndef NO_P1
                    for (int rep_ = 0; rep_ < DUP_P1; ++rep_) { pg8::gemm_phase<EpiInProj>(L, g, S, E, tid); asm volatile("s_waitcnt vmcnt(0)" ::: "memory"); __syncthreads(); }
#endif

                } else if (kind == 1) {
                    {
                        if (bx < 1024) gmlp_dma(L, bV, (bx >> 2) * 128, bx & 3, 0, tid);
                        int par = 0, gprev = -1;
                        for (int u = bx; u < 1024; u += G) {
                            const int g = u & 3, blk = u >> 2;
                            const int un = u + G; const bool hn = un < 1024;
                            gmlp_unit(L, bU, bV, bVST, a.in[4] + (size_t)(l * 4 + g) * 16384, a.in[5] + (l * 4 + g) * 128, a.in[2] + l * GW, a.in[3] + l * GW, blk * 128, g, tid,
                                      par, g != gprev, hn, (un >> 2) * 128, un & 3);
                            par ^= 1; gprev = g;
                        }
                    }
                    for (int sg = bx; sg < 256; sg += G) {
                        const int bh = sg >> 2, seg = sg & 3, hh = bh & 7, bl = bh >> 3, c0 = seg * 16;
                        const size_t toff0 = (size_t)(bl * SEQ + c0 * 64) * DM + hh * 128;
                        hgrn_b1_dma(L, bF + toff0, bI + toff0, tid);
                        asm volatile("s_waitcnt vmcnt(0)" ::: "memory");
                        __syncthreads();
                        float sst[8][4]; float cumdec = 1.f;
                        const float lb1 = lbv[l * 1024 + hh * 128 + (tid & 127)];
#pragma unroll
                        for (int vt = 0; vt < 8; ++vt)
#pragma unroll
                            for (int i = 0; i < 4; ++i) sst[vt][i] = 0.f;
                        for (int i = 0; i < 16; ++i) {
                            const int u = bh * 64 + c0 + i; const bool hn = i < 15;
                            const size_t toffn = toff0 + (size_t)(hn ? i + 1 : i) * 64 * DM;
                            hgrn_b1_unit(L, bS + (size_t)u * 16384, bD + (size_t)u * 128, sst, cumdec, lb1, tid, hn, bF + toffn, bI + toffn);
                        }
                        {
                            const int wid = tid >> 6, fr = tid & 15, fq = (tid & 63) >> 4;
                            float* sb = (float*)(P + P_SEGB) + (size_t)sg * 16384;
#pragma unroll
                            for (int vt = 0; vt < 8; ++vt) *(f32x4*)(sb + (size_t)(16 * vt + fr) * 128 + 16 * wid + 4 * fq) = (f32x4){sst[vt][0], sst[vt][1], sst[vt][2], sst[vt][3]};
                            if (tid < 128) ((float*)(P + P_SEGA))[(size_t)sg * 128 + tid] = cumdec;
                        }
                    }
                } else if (kind == 2) {
                } else if (kind == 3) {
                    for (int sg = bx; sg < 256; sg += G) {
                        const int wid = tid >> 6, fr = tid & 15, fq = (tid & 63) >> 4;
                        const int bh = sg >> 2, seg = sg & 3, hh = bh & 7, bl = bh >> 3, c0 = seg * 16;
                        const size_t toff0 = (size_t)(bl * SEQ + c0 * 64) * DM + hh * 128;
                        hgrn_b3_dma(L, bQ + toff0, bF + toff0, tid);
                        hgrn_b3_dma_v(L, bI + toff0, tid);
                        f32x4 sq0[4], sq1[4];
                        {
                            float z_ = 0.f; asm volatile("" : "+v"(z_));
#pragma unroll
                            for (int ks = 0; ks < 4; ++ks) { sq0[ks] = (f32x4){z_, z_, z_, z_}; sq1[ks] = (f32x4){z_, z_, z_, z_}; }
                            for (int j = 0; j < seg; ++j) {
                                const float* sbj = (const float*)(P + P_SEGB) + (size_t)(bh * 4 + j) * 16384 + (size_t)(16 * wid + fr) * 128 + fq * 8;
                                const float* saj = (const float*)(P + P_SEGA) + (size_t)(bh * 4 + j) * 128 + fq * 8;
#pragma unroll
                                for (int ks = 0; ks < 4; ++ks) {
                                    sq0[ks] = *(const f32x4*)(saj + ks * 32) * sq0[ks] + *(const f32x4*)(sbj + ks * 32);
                                    sq1[ks] = *(const f32x4*)(saj + ks * 32 + 4) * sq1[ks] + *(const f32x4*)(sbj + ks * 32 + 4);
                                }
                            }
                        }
                        const float lb3 = lbv[l * 1024 + hh * 128 + (tid & 127)];
                        asm volatile("s_waitcnt vmcnt(0)" ::: "memory");
                        __syncthreads();
                        for (int i = 0; i < 16; ++i) {
                            const int u = bh * 64 + c0 + i; const bool hn = i < 15;
                            const size_t toff = toff0 + (size_t)i * 64 * DM, toffn = toff0 + (size_t)(hn ? i + 1 : i) * 64 * DM;
                            hgrn_b3_unit(L, bI + toff, bZO + toff, bS + (size_t)u * 16384, sq0, sq1, bD + (size_t)u * 128, lb3, a.in[8] + l * 128, tid, hn, bQ + toffn, bF + toffn, bI + toffn);
                        }
                    }
                } else {
                    for (int pass = 0; pass < 2; ++pass) {
                        pg8::Gemm g{pass == 0 ? bU : bI, (const bf16_t*)(wl + (pass == 0 ? WL_A : WL_B)), MTOT, DM, pass == 0 ? GW : DM};
                        pg8::StaticOrder S; S.init(MTOT, DM, G, bx);
                        EpiMix E{pass == 0 ? bGA : bGB, MIX, pass == 0 ? 1 : 0};

#ifndef NO_P3
                        pg8::gemm_phase<EpiMix>(L, g, S, E, tid);
#endif

                    }
                }
            } else if (k == 5 || k == 7) {
                pg8::Gemm g{k == 5 ? MIX : H1, (const bf16_t*)(wl + (k == 5 ? WL_O : WL_2)), MTOT, DM, k == 5 ? DM : DFF};
                pg8::StaticOrder S; S.init(MTOT, DM, G, bx);
                EpiResid E{XB, SSP, L + 131072};

#ifndef NO_P4
                pg8::gemm_phase<EpiResid>(L, g, S, E, tid);
#endif

            } else {
                pg8::Gemm g{XB, (const bf16_t*)(wl + WL_1), MTOT, DFF, DM};
                pg8::StaticOrder S; S.init(MTOT, DFF, G, bx);
                EpiFF1 E{SSP, H1};

#ifndef NO_P5
                pg8::gemm_phase<EpiFF1>(L, g, S, E, tid);
#endif

            }
        }
#undef a
        if (st + 1 < st_hi) {
            if (st_hi > 1000) grid.sync();
            else { XcdBarrier xbar; xbar.bar = (unsigned*)(kp->ws + WS_BAR); xbar.x = xb_xcc_id(); xbar.st = (volatile LAS unsigned*)(L + LDS_BYTES - 16); xcd_barrier(xbar); }
        }
    }
}

extern "C" void kernel_launch(void* const* d_in, const int* in_sizes, int n_in, void* d_out, int out_size, void* d_ws, size_t ws_size, hipStream_t stream) {
    static int grid = 0;
    if (grid == 0) {
        if (n_in != 16 || out_size != MTOT * DM || ws_size < WS_END) { fprintf(stderr, "kernel_launch: unexpected shapes / workspace (%d inputs, out %d, ws %zu < %zu)\n", n_in, out_size, ws_size, (size_t)WS_END); grid = -1; return; }
        int dev = 0, cus = 0, per_cu = 0;
        hipGetDevice(&dev); hipDeviceGetAttribute(&cus, hipDeviceAttributeMultiprocessorCount, dev);
        hipOccupancyMaxActiveBlocksPerMultiprocessor(&per_cu, (const void*)mega_fwd, 512, 0);
        (void)hipGetLastError();
        if (per_cu < 1) per_cu = 1;
        grid = cus * 1;
        if (grid <= 0) grid = 256;
    }
    if (grid < 0) return;
    (void)hipMemsetAsync((char*)d_ws + WS_BAR, 0, 16384, stream);
    Args a{};
    for (int i = 0; i < 16; ++i) a.in[i] = (const float*)d_in[i];
    a.out = (float*)d_out; a.ws = (unsigned char*)d_ws;
#if MK_MULTI
#ifdef DBG_STOP
    for (int st = 0; st < DBG_STOP; ++st) { a.lo = st; a.hi = st + 1; hipLaunchKernelGGL(mega_fwd, dim3(grid), dim3(512), 0, stream, a); }
    a.lo = 100; a.hi = 101; hipLaunchKernelGGL(mega_fwd, dim3(grid), dim3(512), 0, stream, a);
#else
    for (int st = 0; st < 19; ++st) { a.lo = st; a.hi = st + 1; hipLaunchKernelGGL(mega_fwd, dim3(grid), dim3(512), 0, stream, a); }
#endif
#else
    a.lo = 0; a.hi = 19;
    void* args[] = {&a};
    hipError_t e = hipLaunchCooperativeKernel((const void*)mega_fwd, dim3(grid), dim3(512), args, 0, stream);
    if (e != hipSuccess) fprintf(stderr, "cooperative launch failed: %s (grid %d)\n", hipGetErrorString(e), grid);
#endif
}
```

```cpp
#include <hip/hip_runtime.h>
#include <hip/hip_cooperative_groups.h>
#include <cstdio>
#include <cstdint>
namespace cg = cooperative_groups;
#define MK_MULTI 0
#ifndef DUP_B1
#define DUP_B1 1
#endif
#ifndef DUP_P1
#define DUP_P1 1
#endif

#define LAS __attribute__((address_space(3)))
typedef unsigned short bf16_t;
typedef short bf16x8 __attribute__((ext_vector_type(8)));
typedef float f32x4 __attribute__((ext_vector_type(4)));
typedef float f32x2 __attribute__((ext_vector_type(2)));
typedef unsigned u32x4 __attribute__((ext_vector_type(4)));
typedef unsigned u32x2 __attribute__((ext_vector_type(2)));

constexpr int DM = 1024, BATCH = 8, SEQ = 4096, MTOT = BATCH * SEQ;
constexpr int INC = 7168, DFF = 4096, GW = 512;
constexpr float EPS = 1e-6f;

__device__ __forceinline__ float bf2f(unsigned v) { return __uint_as_float(v << 16); }
typedef __bf16 bf16x2_t __attribute__((ext_vector_type(2)));
__device__ __forceinline__ unsigned cvt_pk_bf16(float lo, float hi) { f32x2 v = {lo, hi}; bf16x2_t b = __builtin_convertvector(v, bf16x2_t); return __builtin_bit_cast(unsigned, b); }
__device__ __forceinline__ float fast_rcp(float x) { return __builtin_amdgcn_rcpf(x); }
__device__ __forceinline__ float sigmoidf_(float x) { return fast_rcp(1.0f + __expf(-x)); }
__device__ __forceinline__ float siluf_(float x) { return x * sigmoidf_(x); }
__device__ __forceinline__ f32x2 gelu_pk(f32x2 v) {
    const f32x2 av = __builtin_elementwise_abs(v), d = av * 0.2316418882f + 1.0f;
    f32x2 t; t.x = __builtin_amdgcn_rcpf(d.x); t.y = __builtin_amdgcn_rcpf(d.y);
    f32x2 q = t * 0.5307027145f + (-0.7265760135f); q = q * t + 0.7107068705f; q = q * t + (-0.142248368f); q = q * t + 0.127414796f; q = q * t;
    const f32x2 s = (v * v) * (-0.72134752044f);
    f32x2 e; e.x = __builtin_amdgcn_exp2f(s.x); e.y = __builtin_amdgcn_exp2f(s.y);
    const f32x2 m = v * (q * e), r = v - m;
    f32x2 o; o.x = v.x < 0.f ? m.x : r.x; o.y = v.y < 0.f ? m.y : r.y; return o;
}
__device__ __forceinline__ float wave_sum(float v) {
#pragma unroll
    for (int o = 1; o < 64; o <<= 1) v += __shfl_xor(v, o);
    return v;
}

namespace pg8 {
constexpr int BM = 256, BK = 64, HALF = 128, HTB = HALF * BK * 2, STAGE_BYTES = 8 * HTB, NXCD = 8, WGM = 8;
__host__ __device__ __forceinline__ int lds_byte(int r, int c) { const int st = (r >> 4) * 2 + (c >> 5), rr = r & 15, cc = c & 31, ob = rr * 64 + cc * 2; return st * 1024 + (ob ^ (((ob >> 9) & 1) << 5)); }
__host__ __device__ __forceinline__ void stage_rc(int b, int& R, int& C) { const int st = b / 1024, sb = b % 1024, swz = sb ^ (((sb >> 9) & 1) << 5); R = (st >> 1) * 16 + swz / 64; C = (st & 1) * 32 + (swz % 64) / 2; }
__host__ __device__ __forceinline__ int perm32(int rho) { const int n = rho >> 4, i = rho & 15; return 8 * (i >> 2) + 4 * n + (i & 3); }
struct Unit { int pm, pn; };
struct Gemm { const bf16_t* A; const bf16_t* Bt; int M, N, K; };
struct StaticOrder {
    int nM, nN, nwg, G, c;
    __device__ void init(int M, int N, int G_, int c_) { nM = M / BM; nN = N / BM; nwg = nM * nN; G = G_; c = c_; }
    __device__ bool next(int i, Unit& u) const {
        const long L = (long)i * G + c; if (L >= nwg) return false;
        int wgid = (int)L; { const int q = nwg / NXCD, r = nwg % NXCD, xcd = wgid % NXCD, off = wgid / NXCD; wgid = (xcd < r ? xcd * (q + 1) : r * (q + 1) + (xcd - r) * q) + off; }
        const int nig = WGM * nN, gid = wgid / nig, fm = gid * WGM, gsz = (nM - fm) < WGM ? (nM - fm) : WGM;
        u.pm = fm + ((wgid % nig) % gsz); u.pn = (wgid % nig) / gsz; return true;
    }
};
template <class Epi>
__device__ __forceinline__ void gemm_phase(LAS unsigned char* lds, const Gemm g, const StaticOrder& S, const Epi& E, const int tid) {
    const int wid = __builtin_amdgcn_readfirstlane(tid >> 6), lane = tid & 63, wr = wid >> 2, wc = wid & 3, fr = lane & 15, fq = lane >> 4;
    const int K = g.K, nt = K / BK;
    unsigned voffA[2], voffB[2];
#pragma unroll
    for (int i = 0; i < 2; ++i) { int R, C; stage_rc(tid * 16 + i * 8192, R, C); const int Rb = (R & ~31) + perm32(R & 31);
        voffA[i] = (unsigned)(R * K + C) * 2u; voffB[i] = (unsigned)(Rb * K + C) * 2u; }
    const size_t kstep = (size_t)(BK * 2);
    const size_t hstep = (size_t)HALF * K * 2;
    const size_t tstep = 2 * hstep;
    const unsigned ldsw = (unsigned)wid * 1024u;
    const int aoff = lds_byte(wr * 64 + fr, fq * 8), boff = lds_byte(wc * 32 + fr, fq * 8);
#define PG8_SA(b, h) (((b) * 2 + (h)) * HTB)
#define PG8_SB(b, h) ((4 + (b) * 2 + (h)) * HTB)
#define PG8_STAGE(bufoff, gbase, voff) do { _Pragma("unroll") for (int _i = 0; _i < 2; ++_i) \
        __builtin_amdgcn_global_load_lds((const unsigned*)((const char*)(gbase) + (voff)[_i]), (LAS unsigned*)(lds + (bufoff) + ldsw + _i * 8192), 16, 0, 0); } while (0)
#define PG8_LDA(dst, b, h) do { _Pragma("unroll") for (int m = 0; m < 4; ++m) _Pragma("unroll") for (int k = 0; k < 2; ++k) dst[m][k] = *(const LAS bf16x8*)(lds + PG8_SA(b, h) + aoff + m * 2048 + k * 1024); } while (0)
#define PG8_LDB(dst, b, h) do { _Pragma("unroll") for (int n = 0; n < 2; ++n) _Pragma("unroll") for (int k = 0; k < 2; ++k) dst[n][k] = *(const LAS bf16x8*)(lds + PG8_SB(b, h) + boff + n * 2048 + k * 1024); } while (0)
#define PG8_MMA(ai, bj, At, Bt) do { __builtin_amdgcn_s_setprio(1); _Pragma("unroll") for (int m = 0; m < 4; ++m) _Pragma("unroll") for (int n = 0; n < 2; ++n) _Pragma("unroll") for (int k = 0; k < 2; ++k) \
        acc[ai][bj][m][n] = __builtin_amdgcn_mfma_f32_16x16x32_bf16(Bt[n][k], At[m][k], acc[ai][bj][m][n], 0, 0, 0); __builtin_amdgcn_s_setprio(0); } while (0)
#define PG8_WAIT_V(n) asm volatile("s_waitcnt vmcnt(" #n ")" ::: "memory")
#define PG8_WAIT_L(n) asm volatile("s_waitcnt lgkmcnt(" #n ")" ::: "memory")
#define PG8_BAR __builtin_amdgcn_s_barrier()
#define PG8_SCHED __builtin_amdgcn_sched_barrier(0)
    Unit cur, nxt; int ui = 0;
    if (!S.next(0, cur)) return;
    f32x4 acc[2][2][4][2];
    E.init(acc, cur, wr, wc, fr, fq);
    bf16x8 At[4][2], B0[2][2], B1[2][2];
    const char* cA = (const char*)g.A + (size_t)cur.pm * tstep; const char* cB = (const char*)g.Bt + (size_t)cur.pn * tstep;
    PG8_STAGE(PG8_SB(0, 0), cB, voffB); PG8_STAGE(PG8_SB(0, 1), cB + hstep, voffB); PG8_STAGE(PG8_SA(0, 0), cA, voffA); PG8_STAGE(PG8_SA(0, 1), cA + hstep, voffA);
    if (wr == 1) PG8_BAR;
    PG8_WAIT_V(2); PG8_BAR;
    PG8_STAGE(PG8_SB(1, 0), cB + kstep, voffB); PG8_STAGE(PG8_SA(1, 0), cA + kstep, voffA); PG8_STAGE(PG8_SB(1, 1), cB + hstep + kstep, voffB);
    PG8_WAIT_V(6); PG8_BAR;
    for (;;) {
        const bool has_next = S.next(ui + 1, nxt);
        const char* nA = has_next ? (const char*)g.A + (size_t)nxt.pm * tstep : cA; const char* nB = has_next ? (const char*)g.Bt + (size_t)nxt.pn * tstep : cB;
        for (int t = 0; t < nt; t += 2) {
            const bool last = (t == nt - 2);
            const char* a1 = cA + (size_t)(t + 1) * kstep;
            const char* a2 = last ? nA : cA + (size_t)(t + 2) * kstep; const char* b2 = last ? nB : cB + (size_t)(t + 2) * kstep;
            const char* a3 = a2 + kstep; const char* b3 = b2 + kstep;
            PG8_LDB(B0, 0, 0); PG8_LDB(B1, 0, 1); PG8_SCHED; PG8_LDA(At, 0, 0); PG8_STAGE(PG8_SA(1, 1), a1 + hstep, voffA);
            PG8_WAIT_V(8); PG8_WAIT_L(0); PG8_BAR; PG8_MMA(0, 0, At, B0); PG8_MMA(0, 1, At, B1); PG8_BAR; PG8_SCHED;
            PG8_LDA(At, 0, 1); PG8_STAGE(PG8_SB(0, 0), b2, voffB); PG8_STAGE(PG8_SB(0, 1), b2 + hstep, voffB); PG8_STAGE(PG8_SA(0, 0), a2, voffA);
            PG8_WAIT_V(8); PG8_WAIT_L(0); PG8_BAR; PG8_MMA(1, 0, At, B0); PG8_MMA(1, 1, At, B1); PG8_BAR; PG8_SCHED;
            PG8_LDB(B0, 1, 0); PG8_LDB(B1, 1, 1); PG8_SCHED; PG8_LDA(At, 1, 0); PG8_STAGE(PG8_SA(0, 1), a2 + hstep, voffA);
            PG8_WAIT_V(8); PG8_WAIT_L(0); PG8_BAR; PG8_MMA(0, 0, At, B0); PG8_MMA(0, 1, At, B1); PG8_BAR; PG8_SCHED;
            PG8_LDA(At, 1, 1); PG8_STAGE(PG8_SB(1, 0), b3, voffB); PG8_STAGE(PG8_SB(1, 1), b3 + hstep, voffB); PG8_STAGE(PG8_SA(1, 0), a3, voffA);
            PG8_WAIT_V(8); PG8_WAIT_L(0); PG8_BAR; PG8_MMA(1, 0, At, B0); PG8_MMA(1, 1, At, B1); PG8_BAR; PG8_SCHED;
        }
        if (wr == 0) PG8_BAR;
        E(acc, cur, wr, wc, fr, fq);
        if (!has_next) break;
        E.init(acc, nxt, wr, wc, fr, fq);
        cur = nxt; cA = nA; cB = nB; ++ui;
        if (wr == 1) PG8_BAR;
    }
    PG8_WAIT_V(0);
    PG8_BAR;
#undef PG8_SA
#undef PG8_SB
#undef PG8_STAGE
#undef PG8_LDA
#undef PG8_LDB
#undef PG8_MMA
#undef PG8_WAIT_V
#undef PG8_WAIT_L
#undef PG8_BAR
#undef PG8_SCHED
}
}
using pg8::Unit;

constexpr size_t WS_LBV = 0;
constexpr size_t WS_W = 1u << 20;
constexpr size_t WL_IN = 0, WL_A = WL_IN + (size_t)INC * DM * 2, WL_B = WL_A + (size_t)DM * GW * 2, WL_O = WL_B + (size_t)DM * DM * 2,
                 WL_1 = WL_O + (size_t)DM * DM * 2, WL_2 = WL_1 + (size_t)DFF * DM * 2, WL_SIZE = WL_2 + (size_t)DM * DFF * 2;
constexpr size_t WS_XB = WS_W + WL_SIZE;
constexpr size_t WS_SSP = WS_XB + (size_t)MTOT * DM * 2;
constexpr size_t WS_P = WS_SSP + (size_t)MTOT * 16 * 4;
constexpr size_t P_U = 0, P_V = P_U + (size_t)MTOT * GW * 2, P_Q = P_V + (size_t)MTOT * GW * 2, P_F = P_Q + (size_t)MTOT * DM * 2, P_I = P_F + (size_t)MTOT * DM * 2,
                 P_ZO = P_I + (size_t)MTOT * DM * 2, P_GA = P_ZO + (size_t)MTOT * DM * 2, P_GB = P_GA + (size_t)MTOT * DM  , P_VST = P_GB + (size_t)MTOT * DM,
                 P_D = P_VST + (size_t)MTOT * 8 * 8, P_SEGB = P_D + (size_t)4096 * 128 * 4, P_SEGA = P_SEGB + (size_t)256 * 16384 * 4, P_END = P_SEGA + (size_t)256 * 128 * 4;
constexpr size_t WS_H1 = WS_P;
constexpr size_t WS_END = WS_P + (P_END > (size_t)MTOT * DFF * 2 ? P_END : (size_t)MTOT * DFF * 2);
static_assert(WS_END <= 536870912ull, "workspace map exceeds 512 MiB");

__device__ __forceinline__ float rstd4(const f32x4 p) { return rsqrtf(((p[0] + p[1]) + (p[2] + p[3])) * (1.0f / DM) + EPS); }

struct EpiInProj {
    const float* ssp; unsigned char* P; f32x2* vst;
    __device__ __forceinline__ void init(f32x4 (&acc)[2][2][4][2], const Unit&, int, int, int, int) const {
#pragma unroll
        for (int a_ = 0; a_ < 2; ++a_)
#pragma unroll
            for (int b_ = 0; b_ < 2; ++b_)
#pragma unroll
                for (int m_ = 0; m_ < 4; ++m_)
#pragma unroll
                    for (int n_ = 0; n_ < 2; ++n_) acc[a_][b_][m_][n_] = (f32x4){0.f, 0.f, 0.f, 0.f};
    }
    __device__ __forceinline__ void operator()(const f32x4 (&acc)[2][2][4][2], const Unit& u, int wr, int wc, int fr, int fq) const {
        const int pn = u.pn; size_t boff; int ldc, colt, act;
        if (pn < 2) { boff = P_U; ldc = GW; colt = pn * 256; act = 1; }
        else if (pn < 4) { boff = P_V; ldc = GW; colt = (pn - 2) * 256; act = 2; }
        else if (pn < 8) { boff = P_Q; ldc = DM; colt = (pn - 4) * 256; act = 3; }
        else if (pn < 12) { boff = P_F; ldc = DM; colt = (pn - 8) * 256; act = 0; }
        else if (pn < 16) { boff = P_I; ldc = DM; colt = (pn - 12) * 256; act = 0; }
        else if (pn < 20) { boff = P_ZO; ldc = DM; colt = (pn - 16) * 256; act = 3; }
        else if (pn < 24) { boff = P_GA; ldc = DM / 2; colt = (pn - 20) * 256; act = 4; }
        else { boff = P_GB; ldc = DM / 2; colt = (pn - 24) * 256; act = 4; }
        bf16_t* base = (bf16_t*)(P + boff);
        const int col0 = colt + wc * 32 + 8 * fq;
        f32x4 pr[2][4];
#pragma unroll
        for (int ai = 0; ai < 2; ++ai)
#pragma unroll
            for (int m = 0; m < 4; ++m) pr[ai][m] = *(const f32x4*)(ssp + (size_t)(u.pm * 256 + ai * 128 + wr * 64 + m * 16 + fr) * 4);
#pragma unroll
        for (int ai = 0; ai < 2; ++ai)
#pragma unroll
            for (int m = 0; m < 4; ++m) {
                const int row = u.pm * 256 + ai * 128 + wr * 64 + m * 16 + fr;
                const float rs = rstd4(pr[ai][m]);
                bf16_t* rowp = base + (size_t)row * ldc + col0;
                float s1 = 0.f, s2 = 0.f;
#pragma unroll
                for (int bj = 0; bj < 2; ++bj) {
                    f32x4 v0 = acc[ai][bj][m][0] * rs, v1 = acc[ai][bj][m][1] * rs;
                    if (act == 1 || act == 2) {
                        f32x2 a = gelu_pk((f32x2){v0[0], v0[1]}), b = gelu_pk((f32x2){v0[2], v0[3]}), c = gelu_pk((f32x2){v1[0], v1[1]}), d = gelu_pk((f32x2){v1[2], v1[3]});
                        v0 = (f32x4){a.x, a.y, b.x, b.y}; v1 = (f32x4){c.x, c.y, d.x, d.y};
                        if (act == 2) {
                            s1 += ((v0[0] + v0[1]) + (v0[2] + v0[3])) + ((v1[0] + v1[1]) + (v1[2] + v1[3]));
                            s2 += ((v0[0] * v0[0] + v0[1] * v0[1]) + (v0[2] * v0[2] + v0[3] * v0[3])) + ((v1[0] * v1[0] + v1[1] * v1[1]) + (v1[2] * v1[2] + v1[3] * v1[3]));
                        }
                    } else if (act == 3) {
#pragma unroll
                        for (int e = 0; e < 4; ++e) { v0[e] = siluf_(v0[e]); v1[e] = siluf_(v1[e]); }
                    } else if (act == 4) {
                        unsigned q0 = 0u, q1 = 0u;
#pragma unroll
                        for (int e = 0; e < 4; ++e) { q0 |= (unsigned)(sigmoidf_(v0[e]) * 255.0f + 0.5f) << (8 * e); q1 |= (unsigned)(sigmoidf_(v1[e]) * 255.0f + 0.5f) << (8 * e); }
                        *(u32x2*)((unsigned char*)base + (size_t)row * DM + col0 + bj * 128) = (u32x2){q0, q1};
                        continue;
                    }
                    u32x4 w; w.x = cvt_pk_bf16(v0[0], v0[1]); w.y = cvt_pk_bf16(v0[2], v0[3]); w.z = cvt_pk_bf16(v1[0], v1[1]); w.w = cvt_pk_bf16(v1[2], v1[3]);
                    *(u32x4*)(rowp + bj * 128) = w;
                }
                if (act == 2) {
                    s1 += __shfl_xor(s1, 16); s1 += __shfl_xor(s1, 32); s2 += __shfl_xor(s2, 16); s2 += __shfl_xor(s2, 32);
                    if (fq == 0) vst[(size_t)row * 8 + (pn - 2) * 4 + wc] = (f32x2){s1, s2};
                }
            }
    }
};
struct EpiMix {
    const unsigned char* G; bf16_t* MIX; int first;
    __device__ __forceinline__ void init(f32x4 (&acc)[2][2][4][2], const Unit&, int, int, int, int) const {
#pragma unroll
        for (int a_ = 0; a_ < 2; ++a_)
#pragma unroll
            for (int b_ = 0; b_ < 2; ++b_)
#pragma unroll
                for (int m_ = 0; m_ < 4; ++m_)
#pragma unroll
                    for (int n_ = 0; n_ < 2; ++n_) acc[a_][b_][m_][n_] = (f32x4){0.f, 0.f, 0.f, 0.f};
    }
    __device__ __forceinline__ void operator()(const f32x4 (&acc)[2][2][4][2], const Unit& u, int wr, int wc, int fr, int fq) const {
        const int col0 = u.pn * 256 + wc * 32 + 8 * fq;
        u32x2 gq[2][4][2];
#pragma unroll
        for (int ai = 0; ai < 2; ++ai)
#pragma unroll
            for (int m = 0; m < 4; ++m) {
                const size_t off = (size_t)(u.pm * 256 + ai * 128 + wr * 64 + m * 16 + fr) * DM + col0;
#pragma unroll
                for (int bj = 0; bj < 2; ++bj) gq[ai][m][bj] = *(const u32x2*)(G + off + bj * 128);
            }
#pragma unroll
        for (int ai = 0; ai < 2; ++ai) {
            u32x4 mq[1][4][2];
#pragma unroll
            for (int m = 0; m < 4; ++m) {
                const size_t off = (size_t)(u.pm * 256 + ai * 128 + wr * 64 + m * 16 + fr) * DM + col0;
#pragma unroll
                for (int bj = 0; bj < 2; ++bj) mq[0][m][bj] = first ? (u32x4){0u, 0u, 0u, 0u} : *(const u32x4*)(MIX + off + bj * 128);
            }
#pragma unroll
            for (int m = 0; m < 4; ++m) {
                const size_t off = (size_t)(u.pm * 256 + ai * 128 + wr * 64 + m * 16 + fr) * DM + col0;
#pragma unroll
                for (int bj = 0; bj < 2; ++bj) {
                    const u32x2 g2 = gq[ai][m][bj]; const u32x4 m4 = mq[0][m][bj];
                    constexpr float IG = 1.0f / 255.0f;
                    f32x4 v0 = acc[ai][bj][m][0], v1 = acc[ai][bj][m][1];
                    v0[0] = v0[0] * ((float)(g2.x & 255u) * IG) + bf2f(m4.x & 0xffffu); v0[1] = v0[1] * ((float)((g2.x >> 8) & 255u) * IG) + bf2f(m4.x >> 16);
                    v0[2] = v0[2] * ((float)((g2.x >> 16) & 255u) * IG) + bf2f(m4.y & 0xffffu); v0[3] = v0[3] * ((float)(g2.x >> 24) * IG) + bf2f(m4.y >> 16);
                    v1[0] = v1[0] * ((float)(g2.y & 255u) * IG) + bf2f(m4.z & 0xffffu); v1[1] = v1[1] * ((float)((g2.y >> 8) & 255u) * IG) + bf2f(m4.z >> 16);
                    v1[2] = v1[2] * ((float)((g2.y >> 16) & 255u) * IG) + bf2f(m4.w & 0xffffu); v1[3] = v1[3] * ((float)(g2.y >> 24) * IG) + bf2f(m4.w >> 16);
                    u32x4 w; w.x = cvt_pk_bf16(v0[0], v0[1]); w.y = cvt_pk_bf16(v0[2], v0[3]); w.z = cvt_pk_bf16(v1[0], v1[1]); w.w = cvt_pk_bf16(v1[2], v1[3]);
                    *(u32x4*)(MIX + off + bj * 128) = w;
                }
            }
        }
    }
};
struct EpiResid {
    bf16_t* XB; float* ssp; LAS unsigned char* red;
    __device__ __forceinline__ void init(f32x4 (&acc)[2][2][4][2], const Unit& u, int wr, int wc, int fr, int fq) const {
        const int col0 = u.pn * 256 + wc * 32 + 8 * fq;
#pragma unroll
        for (int ai = 0; ai < 2; ++ai)
#pragma unroll
            for (int m = 0; m < 4; ++m) {
                const size_t off = (size_t)(u.pm * 256 + ai * 128 + wr * 64 + m * 16 + fr) * DM + col0;
#pragma unroll
                for (int bj = 0; bj < 2; ++bj) {
                    const u32x4 q = *(const u32x4*)(XB + off + bj * 128);
                    acc[ai][bj][m][0] = (f32x4){bf2f(q.x & 0xffffu), bf2f(q.x >> 16), bf2f(q.y & 0xffffu), bf2f(q.y >> 16)};
                    acc[ai][bj][m][1] = (f32x4){bf2f(q.z & 0xffffu), bf2f(q.z >> 16), bf2f(q.w & 0xffffu), bf2f(q.w >> 16)};
                }
            }
    }
    __device__ __forceinline__ void operator()(const f32x4 (&acc)[2][2][4][2], const Unit& u, int wr, int wc, int fr, int fq) const {
        const int col0 = u.pn * 256 + wc * 32 + 8 * fq;
#pragma unroll
        for (int ai = 0; ai < 2; ++ai)
#pragma unroll
            for (int m = 0; m < 4; ++m) {
                const int rl = ai * 128 + wr * 64 + m * 16 + fr;
                const size_t off = (size_t)(u.pm * 256 + rl) * DM + col0;
                float ss = 0.f;
#pragma unroll
                for (int bj = 0; bj < 2; ++bj) {
                    const f32x4 v0 = acc[ai][bj][m][0], v1 = acc[ai][bj][m][1];
                    ss += ((v0[0] * v0[0] + v0[1] * v0[1]) + (v0[2] * v0[2] + v0[3] * v0[3])) + ((v1[0] * v1[0] + v1[1] * v1[1]) + (v1[2] * v1[2] + v1[3] * v1[3]));
                    u32x4 w; w.x = cvt_pk_bf16(v0[0], v0[1]); w.y = cvt_pk_bf16(v0[2], v0[3]); w.z = cvt_pk_bf16(v1[0], v1[1]); w.w = cvt_pk_bf16(v1[2], v1[3]);
                    *(u32x4*)(XB + off + bj * 128) = w;
                }
                ss += __shfl_xor(ss, 16); ss += __shfl_xor(ss, 32);
                if (fq == 0) *(LAS float*)(red + (rl * 4 + wc) * 4) = ss;
            }
        asm volatile("s_waitcnt lgkmcnt(0)" ::: "memory"); __builtin_amdgcn_s_barrier(); asm volatile("" ::: "memory");
        const int t = (wr * 4 + wc) * 64 + fq * 16 + fr;
        if (t < 256) { const f32x4 p = *(const LAS f32x4*)(red + t * 16); ssp[(size_t)(u.pm * 256 + t) * 4 + u.pn] = (p[0] + p[1]) + (p[2] + p[3]); }
    }
};
struct EpiFF1 {
    const float* ssp; bf16_t* H;
    __device__ __forceinline__ void init(f32x4 (&acc)[2][2][4][2], const Unit&, int, int, int, int) const {
#pragma unroll
        for (int a_ = 0; a_ < 2; ++a_)
#pragma unroll
            for (int b_ = 0; b_ < 2; ++b_)
#pragma unroll
                for (int m_ = 0; m_ < 4; ++m_)
#pragma unroll
                    for (int n_ = 0; n_ < 2; ++n_) acc[a_][b_][m_][n_] = (f32x4){0.f, 0.f, 0.f, 0.f};
    }
    __device__ __forceinline__ void operator()(const f32x4 (&acc)[2][2][4][2], const Unit& u, int wr, int wc, int fr, int fq) const {
        const int col0 = u.pn * 256 + wc * 32 + 8 * fq;
        f32x4 pr[2][4];
#pragma unroll
        for (int ai = 0; ai < 2; ++ai)
#pragma unroll
            for (int m = 0; m < 4; ++m) pr[ai][m] = *(const f32x4*)(ssp + (size_t)(u.pm * 256 + ai * 128 + wr * 64 + m * 16 + fr) * 4);
#pragma unroll
        for (int ai = 0; ai < 2; ++ai)
#pragma unroll
            for (int m = 0; m < 4; ++m) {
                const int row = u.pm * 256 + ai * 128 + wr * 64 + m * 16 + fr;
                const float rs = rstd4(pr[ai][m]);
                bf16_t* rowp = H + (size_t)row * DFF + col0;
#pragma unroll
                for (int bj = 0; bj < 2; ++bj) {
                    f32x4 v0 = acc[ai][bj][m][0], v1 = acc[ai][bj][m][1];
#pragma unroll
                    for (int e = 0; e < 4; ++e) { const float a = fmaxf(v0[e], 0.f), b = fmaxf(v1[e], 0.f); v0[e] = a * a; v1[e] = b * b; }
                    v0 = v0 * (rs * rs); v1 = v1 * (rs * rs);
                    u32x4 w; w.x = cvt_pk_bf16(v0[0], v0[1]); w.y = cvt_pk_bf16(v0[2], v0[3]); w.z = cvt_pk_bf16(v1[0], v1[1]); w.w = cvt_pk_bf16(v1[2], v1[3]);
                    *(u32x4*)(rowp + bj * 128) = w;
                }
            }
    }
};

constexpr int LDS_BYTES = 147456;

struct Args { const float* in[16]; float* out; unsigned char* ws; int lo, hi; };

struct P0Item { const float* W; bf16_t* WT; const float* gsc; int K, N, k0, n0; };
__device__ __forceinline__ P0Item p0_decode(const __attribute__((address_space(4))) Args* kp, int it, int l) {
    constexpr int T_IN = 448, T_A = 32, T_B = 64, T_O = 64, T_1 = 256, T_2 = 256, T_L = T_IN + T_A + T_B + T_O + T_1 + T_2;
    int r = it; unsigned char* wl = kp->ws + WS_W;
    P0Item p;
    if (r < T_IN) { p.W = kp->in[1] + (size_t)l * DM * INC; p.K = DM; p.N = INC; p.WT = (bf16_t*)(wl + WL_IN); p.gsc = kp->in[11] + l * DM; }
    else if ((r -= T_IN) < T_A) { p.W = kp->in[6] + (size_t)l * GW * DM; p.K = GW; p.N = DM; p.WT = (bf16_t*)(wl + WL_A); p.gsc = nullptr; }
    else if ((r -= T_A) < T_B) { p.W = kp->in[9] + (size_t)l * DM * DM; p.K = DM; p.N = DM; p.WT = (bf16_t*)(wl + WL_B); p.gsc = nullptr; }
    else if ((r -= T_B) < T_O) { p.W = kp->in[10] + (size_t)l * DM * DM; p.K = DM; p.N = DM; p.WT = (bf16_t*)(wl + WL_O); p.gsc = nullptr; }
    else if ((r -= T_O) < T_1) { p.W = kp->in[13] + (size_t)l * DM * DFF; p.K = DM; p.N = DFF; p.WT = (bf16_t*)(wl + WL_1); p.gsc = kp->in[12] + l * DM; }
    else { r -= T_1; p.W = kp->in[14] + (size_t)l * DFF * DM; p.K = DFF; p.N = DM; p.WT = (bf16_t*)(wl + WL_2); p.gsc = nullptr; }
    const int nblk = p.N / 256; p.k0 = 64 * (r / nblk); p.n0 = 256 * (r % nblk);
    return p;
}
constexpr int P0_NITEMS = 448 + 32 + 64 + 64 + 256 + 256;
__device__ __forceinline__ void p0_load(const P0Item& p, f32x4 (&v)[8], int wid, int lane) {
#pragma unroll
    for (int i = 0; i < 8; ++i) {
        const int kk = p.k0 + wid * 8 + i;
        f32x4 x = __builtin_nontemporal_load((const f32x4*)(p.W + (size_t)kk * p.N + p.n0 + lane * 4));
        if (p.gsc) x = x * p.gsc[kk];
        v[i] = x;
    }
}


__device__ __forceinline__ void p0_transpose_item(const float* W, int K, int N, bf16_t* WT, const float* gsc, LAS float* scr, int item, int lane) {
    const int nblk = N / 32, kb = item / nblk, nb = item % nblk, k0 = 64 * kb, n0 = 32 * nb;
#pragma unroll
    for (int i = 0; i < 32; ++i) { const int kk = 2 * i + (lane >> 5); float w = W[(size_t)(k0 + kk) * N + n0 + (lane & 31)]; if (gsc) w *= gsc[k0 + kk]; scr[kk * 33 + (lane & 31)] = w; }
    asm volatile("s_waitcnt lgkmcnt(0)" ::: "memory");
    const int c = lane & 7;
#pragma unroll
    for (int j = 0; j < 4; ++j) { const int n = (lane >> 3) + 8 * j; const LAS float* s = scr + (8 * c) * 33 + n;
        u32x4 o; o.x = cvt_pk_bf16(s[0 * 33], s[1 * 33]); o.y = cvt_pk_bf16(s[2 * 33], s[3 * 33]); o.z = cvt_pk_bf16(s[4 * 33], s[5 * 33]); o.w = cvt_pk_bf16(s[6 * 33], s[7 * 33]);
        *(u32x4*)(WT + (size_t)(n0 + n) * K + k0 + 8 * c) = o; }
    asm volatile("s_waitcnt lgkmcnt(0)" ::: "memory");
}


constexpr int GM_VZ0 = 73728, GM_VZ1 = 106496;
__device__ __forceinline__ void gmlp_dma(LAS unsigned char* L, const bf16_t* V, int R0, int g, int buf, int tid) {
    const int wu = __builtin_amdgcn_readfirstlane(tid >> 6), lane = tid & 63;
    const int base = buf ? GM_VZ1 : GM_VZ0;
#pragma unroll
    for (int i = 0; i < 4; ++i) {
        const int p = wu * 64 + i * 512 + lane, row = p >> 4, c8 = p & 15;
        __builtin_amdgcn_global_load_lds((const unsigned*)(V + (size_t)(R0 + row) * GW + g * 128 + c8 * 8), (LAS unsigned*)(L + base + (wu * 64 + i * 512) * 16), 16, 0, 0);
    }
}
__device__ __forceinline__ void gmlp_unit(LAS unsigned char* L, bf16_t* U, const bf16_t* V, const f32x2* vst, const float* Wg, const float* bsg,
                                          const float* lng, const float* lnb, int R0, int g, int tid, int buf, bool stage_w, bool has_next, int nR0, int ng_) {
    constexpr int VT = 0, WSo = 34816, MU = 69632, RSo = MU + 512;
    const int wid = tid >> 6, lane = tid & 63, fr = lane & 15, fq = lane >> 4;
    const int VZg = buf ? GM_VZ1 : GM_VZ0;
    const float gc = lng[g * 128 + (tid & 127)], bc = lnb[g * 128 + (tid & 127)], bsv = bsg[16 * wid + fr];
    if (tid < 128) {
        const f32x4* p = (const f32x4*)(vst + (size_t)(R0 + tid) * 8);
        const f32x4 a = p[0], b = p[1], c = p[2], d = p[3];
        const float s1 = (a[0] + a[2]) + (b[0] + b[2]) + (c[0] + c[2]) + (d[0] + d[2]);
        const float s2 = (a[1] + a[3]) + (b[1] + b[3]) + (c[1] + c[3]) + (d[1] + d[3]);
        const float mean = s1 * (1.0f / GW), var = fmaxf(s2 * (1.0f / GW) - mean * mean, 0.f);
        *(LAS float*)(L + MU + tid * 4) = mean; *(LAS float*)(L + RSo + tid * 4) = rsqrtf(var + EPS);
    }
    if (stage_w)
#pragma unroll
    for (int i = 0; i < 8; ++i) {
        const int p = tid + i * 512, q = p >> 5, p4 = (p & 31) * 4;
        f32x4 w = *(const f32x4*)(Wg + q * 128 + p4);
        if (q < 64 && p4 >= 64) w = (f32x4){0.f, 0.f, 0.f, 0.f};
        u32x2 o; o.x = cvt_pk_bf16(w[0], w[1]); o.y = cvt_pk_bf16(w[2], w[3]);
        *(LAS u32x2*)(L + WSo + q * 272 + p4 * 2) = o;
    }
    asm volatile("s_waitcnt vmcnt(0)" ::: "memory");
    __syncthreads();
    if (has_next) gmlp_dma(L, V, nR0, ng_, buf ^ 1, tid);
    u32x2 uq8[8];
#pragma unroll
    for (int ct = 0; ct < 8; ++ct) uq8[ct] = *(const u32x2*)(U + (size_t)(R0 + 16 * wid + fr) * GW + g * 128 + 16 * ct + 4 * fq);
    {
        const int c = tid & 127, pq = tid >> 7;
        unsigned short raw[32];
#pragma unroll
        for (int j = 0; j < 32; ++j) raw[j] = *(const LAS unsigned short*)(L + VZg + (32 * pq + j) * 256 + c * 2);
        unsigned pk[16];
#pragma unroll
        for (int j = 0; j < 32; j += 2) {
            const int p0 = 32 * pq + j;
            const float m0 = *(LAS float*)(L + MU + p0 * 4), r0 = *(LAS float*)(L + RSo + p0 * 4), m1 = *(LAS float*)(L + MU + p0 * 4 + 4), r1 = *(LAS float*)(L + RSo + p0 * 4 + 4);
            const float y0 = (bf2f(raw[j]) - m0) * r0 * gc + bc, y1 = (bf2f(raw[j + 1]) - m1) * r1 * gc + bc;
            pk[j >> 1] = cvt_pk_bf16(y0, y1);
        }
#pragma unroll
        for (int j = 0; j < 4; ++j) *(LAS u32x4*)(L + VT + c * 272 + pq * 64 + j * 16) = (u32x4){pk[4 * j], pk[4 * j + 1], pk[4 * j + 2], pk[4 * j + 3]};
    }
    __syncthreads();
    {
        bf16x8 yb[4];
#pragma unroll
        for (int ks = 0; ks < 4; ++ks) yb[ks] = *(const LAS bf16x8*)(L + WSo + (16 * wid + fr) * 272 + (ks * 32 + fq * 8) * 2);
        const int q = 16 * wid + fr;
#pragma unroll
        for (int ct = 0; ct < 8; ++ct) {
            f32x4 acc = (f32x4){0.f, 0.f, 0.f, 0.f};
#pragma unroll
            for (int ks = 0; ks < 4; ++ks) {
                const bf16x8 xa = *(const LAS bf16x8*)(L + VT + (16 * ct + fr) * 272 + (ks * 32 + fq * 8) * 2);
                acc = __builtin_amdgcn_mfma_f32_16x16x32_bf16(xa, yb[ks], acc, 0, 0, 0);
            }
            bf16_t* up = U + (size_t)(R0 + q) * GW + g * 128 + 16 * ct + 4 * fq;
            const u32x2 uq = uq8[ct];
            u32x2 o;
            o.x = cvt_pk_bf16(bf2f(uq.x & 0xffffu) * (acc[0] + bsv), bf2f(uq.x >> 16) * (acc[1] + bsv));
            o.y = cvt_pk_bf16(bf2f(uq.y & 0xffffu) * (acc[2] + bsv), bf2f(uq.y >> 16) * (acc[3] + bsv));
            *(u32x2*)up = o;
        }
    }
    __syncthreads();
}

constexpr int B1_FZ = 40960, B1_VZ = 57344;
__device__ __forceinline__ void hgrn_b1_dma(LAS unsigned char* L, const bf16_t* Fg, const bf16_t* Vg, int tid) {
    const int wid = __builtin_amdgcn_readfirstlane(tid >> 6), lane = tid & 63;
#pragma unroll
    for (int i = 0; i < 2; ++i) {
        const int p = wid * 64 + i * 512 + lane, row = p >> 4, c8 = p & 15;
        __builtin_amdgcn_global_load_lds((const unsigned*)(Fg + (size_t)row * DM + c8 * 8), (LAS unsigned*)(L + B1_FZ + (wid * 64 + i * 512) * 16), 16, 0, 0);
        __builtin_amdgcn_global_load_lds((const unsigned*)(Vg + (size_t)row * DM + c8 * 8), (LAS unsigned*)(L + B1_VZ + (wid * 64 + i * 512) * 16), 16, 0, 0);
    }
}
__device__ __forceinline__ void hgrn_b1_unit(LAS unsigned char* L, bf16_t* Sout, float* Dout, float (&sst)[8][4], float& cumdec, const float lb, int tid, bool has_next, const bf16_t* nFg, const bf16_t* nVg) {
    constexpr int KET = 0, VT = 18432, TS = 36864;
    const int wid = tid >> 6, lane = tid & 63, fr = lane & 15, fq = lane >> 4;
    const int k = tid & 127, J = tid >> 7;
    unsigned short zf[16], zv[16];
#pragma unroll
    for (int j = 0; j < 16; ++j) { zv[j] = *(const LAS unsigned short*)(L + B1_VZ + (16 * J + j) * 256 + k * 2); zf[j] = *(const LAS unsigned short*)(L + B1_FZ + (16 * J + j) * 256 + k * 2); }
    const float oml = 1.0f - lb;
    float E[16], kk[16]; float run = 1.f;
#pragma unroll
    for (int j = 0; j < 16; ++j) {
        const float z = bf2f(zf[j]), e = __expf(-z), sig = fast_rcp(1.0f + e), f = lb + oml * sig;
        kk[j] = oml * e * sig; run *= f; E[j] = run;
    }
    *(LAS float*)(L + TS + (J * 128 + k) * 4) = run;
#pragma unroll
    for (int j = 0; j < 2; ++j) {
        u32x4 w; w.x = zv[8 * j] | ((unsigned)zv[8 * j + 1] << 16); w.y = zv[8 * j + 2] | ((unsigned)zv[8 * j + 3] << 16); w.z = zv[8 * j + 4] | ((unsigned)zv[8 * j + 5] << 16); w.w = zv[8 * j + 6] | ((unsigned)zv[8 * j + 7] << 16);
        *(LAS u32x4*)(L + VT + k * 144 + J * 32 + j * 16) = w;
    }
    __syncthreads();
    if (has_next) hgrn_b1_dma(L, nFg, nVg, tid);
    const float t0 = *(LAS float*)(L + TS + k * 4), t1 = *(LAS float*)(L + TS + (128 + k) * 4), t2 = *(LAS float*)(L + TS + (256 + k) * 4), t3 = *(LAS float*)(L + TS + (384 + k) * 4);
    const float tail = (J < 1 ? t1 : 1.f) * (J < 2 ? t2 : 1.f) * (J < 3 ? t3 : 1.f);
    {
        const float rt = run * tail;
        unsigned pk[8];
#pragma unroll
        for (int j = 0; j < 16; j += 2) pk[j >> 1] = cvt_pk_bf16(kk[j] * fast_rcp(fmaxf(E[j], 1e-30f)) * rt, kk[j + 1] * fast_rcp(fmaxf(E[j + 1], 1e-30f)) * rt);
        *(LAS u32x4*)(L + KET + k * 144 + J * 32) = (u32x4){pk[0], pk[1], pk[2], pk[3]};
        *(LAS u32x4*)(L + KET + k * 144 + J * 32 + 16) = (u32x4){pk[4], pk[5], pk[6], pk[7]};
    }
    if (J == 0) { Dout[k] = cumdec; cumdec *= (t0 * t1) * (t2 * t3); }
    __syncthreads();
    {
        bf16x8 xa[2];
#pragma unroll
        for (int ks = 0; ks < 2; ++ks) xa[ks] = *(const LAS bf16x8*)(L + KET + (16 * wid + fr) * 144 + (ks * 32 + fq * 8) * 2);
        f32x4 dk = *(const LAS f32x4*)(L + TS + (16 * wid + 4 * fq) * 4);
        dk = dk * *(const LAS f32x4*)(L + TS + (128 + 16 * wid + 4 * fq) * 4); dk = dk * *(const LAS f32x4*)(L + TS + (256 + 16 * wid + 4 * fq) * 4); dk = dk * *(const LAS f32x4*)(L + TS + (384 + 16 * wid + 4 * fq) * 4);
#pragma unroll
        for (int vt = 0; vt < 8; ++vt) {
            f32x4 acc = (f32x4){0.f, 0.f, 0.f, 0.f};
#pragma unroll
            for (int ks = 0; ks < 2; ++ks) {
                const bf16x8 yb = *(const LAS bf16x8*)(L + VT + (16 * vt + fr) * 144 + (ks * 32 + fq * 8) * 2);
                acc = __builtin_amdgcn_mfma_f32_16x16x32_bf16(xa[ks], yb, acc, 0, 0, 0);
            }
            u32x2 o; o.x = cvt_pk_bf16(sst[vt][0], sst[vt][1]); o.y = cvt_pk_bf16(sst[vt][2], sst[vt][3]);
            *(u32x2*)(Sout + (size_t)(16 * vt + fr) * 128 + 16 * wid + 4 * fq) = o;
#pragma unroll
            for (int i = 0; i < 4; ++i) sst[vt][i] = dk[i] * sst[vt][i] + acc[i];
        }
    }
    asm volatile("s_waitcnt vmcnt(0)" ::: "memory");
    __syncthreads();
}

constexpr int B3_FZ = 107008, B3_QZ = 123392, B3_VZ = 86528;
__device__ __forceinline__ void hgrn_b3_dma_v(LAS unsigned char* L, const bf16_t* Vg, int tid) {
    const int wid = __builtin_amdgcn_readfirstlane(tid >> 6), lane = tid & 63;
#pragma unroll
    for (int i = 0; i < 2; ++i) {
        const int p = wid * 64 + i * 512 + lane, row = p >> 4, c8 = p & 15;
        __builtin_amdgcn_global_load_lds((const unsigned*)(Vg + (size_t)row * DM + c8 * 8), (LAS unsigned*)(L + B3_VZ + (wid * 64 + i * 512) * 16), 16, 0, 0);
    }
}
__device__ __forceinline__ void hgrn_b3_dma(LAS unsigned char* L, const bf16_t* Qg, const bf16_t* Fg, int tid) {
    const int wid = __builtin_amdgcn_readfirstlane(tid >> 6), lane = tid & 63;
#pragma unroll
    for (int i = 0; i < 2; ++i) {
        const int p = wid * 64 + i * 512 + lane, row = p >> 4, c8 = p & 15;
        __builtin_amdgcn_global_load_lds((const unsigned*)(Fg + (size_t)row * DM + c8 * 8), (LAS unsigned*)(L + B3_FZ + (wid * 64 + i * 512) * 16), 16, 0, 0);
        __builtin_amdgcn_global_load_lds((const unsigned*)(Qg + (size_t)row * DM + c8 * 8), (LAS unsigned*)(L + B3_QZ + (wid * 64 + i * 512) * 16), 16, 0, 0);
    }
}
__device__ __forceinline__ void hgrn_b3_unit(LAS unsigned char* L, bf16_t* Vg, const bf16_t* ZOg, const bf16_t* Sin, const f32x4 (&sq0)[4], const f32x4 (&sq1)[4], const float* Dc,
                                             const float lb, const float* ng, int tid, bool has_next, const bf16_t* nQg, const bf16_t* nFg, const bf16_t* nVg) {
    constexpr int QE = 0, QP = 25600, KP = 43008, VT = 86528, TS = 104960, OO = KP;
    const int wid = tid >> 6, lane = tid & 63, fr = lane & 15, fq = lane >> 4;
    bf16x8 ybS[4];
    bf16x8 pfq[4];
    constexpr int DZ = 139776;
    if (tid < 32) *(LAS f32x4*)(L + DZ + tid * 16) = *(const f32x4*)(Dc + tid * 4);
#pragma unroll
    for (int ks = 0; ks < 4; ++ks) {
        pfq[ks] = *(const bf16x8*)(Sin + (size_t)(16 * wid + fr) * 128 + ks * 32 + fq * 8);
    }
    const int te = tid >> 3, v0e = (tid & 7) * 16;
    const u32x4 z0 = *(const u32x4*)(ZOg + (size_t)te * DM + v0e), z1 = *(const u32x4*)(ZOg + (size_t)te * DM + v0e + 8);
    {
        const int k = tid & 127, J = tid >> 7;
        unsigned short zv[16], zf[16], zq[16];
#pragma unroll
        for (int j = 0; j < 16; ++j) zv[j] = *(const LAS unsigned short*)(L + B3_VZ + (16 * J + j) * 256 + k * 2);
#pragma unroll
        for (int j = 0; j < 16; ++j) { zf[j] = *(const LAS unsigned short*)(L + B3_FZ + (16 * J + j) * 256 + k * 2); zq[j] = *(const LAS unsigned short*)(L + B3_QZ + (16 * J + j) * 256 + k * 2); }
        const float oml = 1.0f - lb;
        float E[16], kk[16], qp[16]; float run = 1.f;
#pragma unroll
        for (int j = 0; j < 16; ++j) {
            const float z = bf2f(zf[j]), e = __expf(-z), sig = fast_rcp(1.0f + e), f = lb + oml * sig;
            kk[j] = oml * e * sig; run *= f; E[j] = run;
            qp[j] = bf2f(zq[j]) * run;
            *(LAS unsigned short*)(L + QP + (16 * J + j) * 272 + k * 2) = (unsigned short)(cvt_pk_bf16(qp[j], 0.f) & 0xffffu);
        }
        *(LAS float*)(L + TS + (J * 128 + k) * 4) = run;
        __syncthreads();
        if (has_next) hgrn_b3_dma(L, nQg, nFg, tid);
#pragma unroll
        for (int ks = 0; ks < 4; ++ks) {
            float v[8];
            const f32x4 d0 = *(const LAS f32x4*)(L + DZ + (ks * 32 + fq * 8) * 4), d1 = *(const LAS f32x4*)(L + DZ + (ks * 32 + fq * 8 + 4) * 4);
#pragma unroll
            for (int e = 0; e < 4; ++e) { v[e] = bf2f((unsigned)(unsigned short)pfq[ks][e]) + d0[e] * sq0[ks][e]; v[4 + e] = bf2f((unsigned)(unsigned short)pfq[ks][4 + e]) + d1[e] * sq1[ks][e]; }
            const u32x4 w = (u32x4){cvt_pk_bf16(v[0], v[1]), cvt_pk_bf16(v[2], v[3]), cvt_pk_bf16(v[4], v[5]), cvt_pk_bf16(v[6], v[7])};
            ybS[ks] = __builtin_bit_cast(bf16x8, w);
        }
#pragma unroll
        for (int j = 0; j < 2; ++j) {
            u32x4 w; w.x = zv[8 * j] | ((unsigned)zv[8 * j + 1] << 16); w.y = zv[8 * j + 2] | ((unsigned)zv[8 * j + 3] << 16); w.z = zv[8 * j + 4] | ((unsigned)zv[8 * j + 5] << 16); w.w = zv[8 * j + 6] | ((unsigned)zv[8 * j + 7] << 16);
            *(LAS u32x4*)(L + VT + k * 144 + J * 32 + j * 16) = w;
        }
        const float t0 = *(LAS float*)(L + TS + k * 4), t1 = *(LAS float*)(L + TS + (128 + k) * 4), t2 = *(LAS float*)(L + TS + (256 + k) * 4);
        const float r1 = t0, r2 = t0 * t1, r3 = r2 * t2;
        const float erj = J == 0 ? 1.f : (J == 1 ? r1 : (J == 2 ? r2 : r3));
#pragma unroll
        for (int j = 0; j < 16; ++j) *(LAS unsigned short*)(L + QE + (16 * J + j) * 400 + k * 2) = (unsigned short)(cvt_pk_bf16(qp[j] * erj, 0.f) & 0xffffu);
        {
            float kd[16], ke[16];
#pragma unroll
            for (int j = 0; j < 16; ++j) { kd[j] = kk[j] * fast_rcp(fmaxf(E[j], 1e-30f)); ke[j] = kd[j] * run; }
            const float tA = J == 0 ? t1 : t2, tB = t2;
#pragma unroll
            for (int I = 0; I < 4; ++I) {
                if (I >= J) {
                    const float gI = (I - J <= 1) ? 1.f : ((I - J == 2) ? tA : tA * tB);
                    const int base = (I == 0 ? 0 : (I == 1 ? 16 : (I == 2 ? 48 : 96))) + 16 * J;
#pragma unroll
                    for (int j = 0; j < 16; ++j) {
                        const float v = (I == J) ? kd[j] : ke[j] * gI;
                        *(LAS unsigned short*)(L + KP + (base + j) * 272 + k * 2) = (unsigned short)(cvt_pk_bf16(v, 0.f) & 0xffffu);
                    }
                }
            }
        }
    }
    __syncthreads();
#pragma unroll
    for (int rep = 0; rep < 2; ++rep) {
        const int idx = wid + 8 * rep, I = idx >> 2, Jt = idx & 3;
        u32x2 o = (u32x2){0u, 0u};
        if (Jt <= I) {
            const int base = (I == 0 ? 0 : (I == 1 ? 16 : (I == 2 ? 48 : 96))) + 16 * Jt;
            f32x4 acc = (f32x4){0.f, 0.f, 0.f, 0.f};
#pragma unroll
            for (int ks = 0; ks < 4; ++ks) {
                const bf16x8 xa = *(const LAS bf16x8*)(L + KP + (base + fr) * 272 + (ks * 32 + fq * 8) * 2);
                const bf16x8 yb = *(const LAS bf16x8*)(L + QP + (16 * I + fr) * 272 + (ks * 32 + fq * 8) * 2);
                acc = __builtin_amdgcn_mfma_f32_16x16x32_bf16(xa, yb, acc, 0, 0, 0);
            }
            if (Jt == I) {
#pragma unroll
                for (int i = 0; i < 4; ++i) if (4 * fq + i > fr) acc[i] = 0.f;
            }
            o.x = cvt_pk_bf16(acc[0], acc[1]); o.y = cvt_pk_bf16(acc[2], acc[3]);
        }
        *(LAS u32x2*)(L + QE + (16 * I + fr) * 400 + (128 + 16 * Jt + 4 * fq) * 2) = o;
    }
    __syncthreads();
    const f32x4 g0 = *(const f32x4*)(ng + v0e), g1 = *(const f32x4*)(ng + v0e + 4), g2 = *(const f32x4*)(ng + v0e + 8), g3 = *(const f32x4*)(ng + v0e + 12);
    {
        bf16x8 yb[6];
#pragma unroll
        for (int ks = 0; ks < 4; ++ks) yb[ks] = ybS[ks];
#pragma unroll
        for (int ks = 0; ks < 2; ++ks) yb[4 + ks] = *(const LAS bf16x8*)(L + VT + (16 * wid + fr) * 144 + (ks * 32 + fq * 8) * 2);
        f32x4 acc[4];
#pragma unroll
        for (int I = 0; I < 4; ++I) {
            acc[I] = (f32x4){0.f, 0.f, 0.f, 0.f};
#pragma unroll
            for (int ks = 0; ks < 6; ++ks) {
                const bf16x8 xa = *(const LAS bf16x8*)(L + QE + (16 * I + fr) * 400 + (ks * 32 + fq * 8) * 2);
                acc[I] = __builtin_amdgcn_mfma_f32_16x16x32_bf16(xa, yb[ks], acc[I], 0, 0, 0);
            }
        }
#pragma unroll
        for (int I = 0; I < 4; ++I)
#pragma unroll
            for (int i = 0; i < 4; ++i) *(LAS float*)(L + OO + (16 * I + 4 * fq + i) * 528 + (16 * wid + fr) * 4) = acc[I][i];
    }
    __syncthreads();
    if (has_next) hgrn_b3_dma_v(L, nVg, tid);
    {
        const int t = te, v0 = v0e;
        f32x4 ov[4]; float ss = 0.f;
#pragma unroll
        for (int j = 0; j < 4; ++j) { ov[j] = *(const LAS f32x4*)(L + OO + t * 528 + (v0 + 4 * j) * 4); ss += (ov[j][0] * ov[j][0] + ov[j][1] * ov[j][1]) + (ov[j][2] * ov[j][2] + ov[j][3] * ov[j][3]); }
        ss += __shfl_xor(ss, 1); ss += __shfl_xor(ss, 2); ss += __shfl_xor(ss, 4);
        const float rstd = rsqrtf(ss * (1.0f / 128.0f) + EPS);
        u32x4 w0, w1;
        w0.x = cvt_pk_bf16(ov[0][0] * rstd * g0[0] * bf2f(z0.x & 0xffffu), ov[0][1] * rstd * g0[1] * bf2f(z0.x >> 16));
        w0.y = cvt_pk_bf16(ov[0][2] * rstd * g0[2] * bf2f(z0.y & 0xffffu), ov[0][3] * rstd * g0[3] * bf2f(z0.y >> 16));
        w0.z = cvt_pk_bf16(ov[1][0] * rstd * g1[0] * bf2f(z0.z & 0xffffu), ov[1][1] * rstd * g1[1] * bf2f(z0.z >> 16));
        w0.w = cvt_pk_bf16(ov[1][2] * rstd * g1[2] * bf2f(z0.w & 0xffffu), ov[1][3] * rstd * g1[3] * bf2f(z0.w >> 16));
        w1.x = cvt_pk_bf16(ov[2][0] * rstd * g2[0] * bf2f(z1.x & 0xffffu), ov[2][1] * rstd * g2[1] * bf2f(z1.x >> 16));
        w1.y = cvt_pk_bf16(ov[2][2] * rstd * g2[2] * bf2f(z1.y & 0xffffu), ov[2][3] * rstd * g2[3] * bf2f(z1.y >> 16));
        w1.z = cvt_pk_bf16(ov[3][0] * rstd * g3[0] * bf2f(z1.z & 0xffffu), ov[3][1] * rstd * g3[1] * bf2f(z1.z >> 16));
        w1.w = cvt_pk_bf16(ov[3][2] * rstd * g3[2] * bf2f(z1.w & 0xffffu), ov[3][3] * rstd * g3[3] * bf2f(z1.w >> 16));
        *(u32x4*)(Vg + (size_t)t * DM + v0) = w0; *(u32x4*)(Vg + (size_t)t * DM + v0 + 8) = w1;
    }
    asm volatile("s_waitcnt vmcnt(0)" ::: "memory");
    __syncthreads();
}


#define XB_TMO      128
#define XB_XCNT(j)  (256  + 64 * (j))
#define XB_XSUB(j)  (1280 + 64 * (j))
#define XB_XGEN(j)  (2304 + 64 * (j))
#define XB_TOP      3328
#define XB_TOPGEN   3392
#define XCD_BAR_WORDS 3456
#define XB_SPIN_CAP (1u << 22)
__device__ __forceinline__ unsigned xb_ld(unsigned* p)              { return __hip_atomic_load(p, __ATOMIC_RELAXED, __HIP_MEMORY_SCOPE_AGENT); }
__device__ __forceinline__ unsigned xb_add(unsigned* p, unsigned v) { return __hip_atomic_fetch_add(p, v, __ATOMIC_RELAXED, __HIP_MEMORY_SCOPE_AGENT); }
__device__ __forceinline__ unsigned xb_xcc_id() { return (unsigned)__builtin_amdgcn_s_getreg((3 << 11) | 20) & 0xFu; }
#define XB_SPIN(cond, bar) do { unsigned _sp = 0; while (cond) { __builtin_amdgcn_s_sleep(1); \
    if ((++_sp & 255u) == 0u) { if (xb_ld(&(bar)[XB_TMO])) break; if (_sp > XB_SPIN_CAP) { atomicAdd(&(bar)[XB_TMO], 1u); break; } } } } while (0)
struct XcdBarrier { unsigned* bar; unsigned x; volatile LAS unsigned* st; };
__device__ __forceinline__ XcdBarrier xcd_barrier_post(unsigned* bar, volatile LAS unsigned* st) {
    XcdBarrier b; b.bar = bar; b.x = xb_xcc_id(); b.st = st;
    if (threadIdx.x == 0) (void)xb_add(&bar[XB_XCNT(b.x)], 1u);
    return b;
}
__device__ __forceinline__ void xcd_barrier_complete(unsigned* bar, unsigned x, unsigned& nloc, unsigned& nx) {
    const unsigned G = gridDim.x * gridDim.y * gridDim.z;
    unsigned sum, cnt, mine, sp = 0u;
    for (;;) {
        sum = 0u; cnt = 0u; mine = 0u;
#pragma unroll
        for (unsigned j = 0; j < 16; ++j) { const unsigned c = xb_ld(&bar[XB_XCNT(j)]); sum += c; cnt += (c > 0u) ? 1u : 0u; mine = (j == x) ? c : mine; }
        if (sum == G) break;
        __builtin_amdgcn_s_sleep(1);
        if ((++sp & 255u) == 0u) { if (xb_ld(&bar[XB_TMO])) break; if (sp > XB_SPIN_CAP) { atomicAdd(&bar[XB_TMO], 1u); break; } }
    }
    nloc = mine > 0u ? mine : 1u; nx = cnt > 0u ? cnt : 1u;
}
__device__ __forceinline__ void xcd_barrier(const XcdBarrier& b) {
    asm volatile("s_waitcnt vmcnt(0)" ::: "memory");
    __syncthreads();
    if (threadIdx.x == 0) {
        unsigned* bar = b.bar;
        __builtin_amdgcn_s_waitcnt(0);
        unsigned nloc = b.st[0], nx = b.st[1];
        if (nloc == 0u) { xcd_barrier_complete(bar, b.x, nloc, nx); b.st[0] = nloc; b.st[1] = nx; }
        const unsigned old = xb_add(&bar[XB_XSUB(b.x)], 1u);
        const unsigned gen = old / nloc;
        if (old + 1u == (gen + 1u) * nloc) {
            __builtin_amdgcn_fence(__ATOMIC_RELEASE, "agent");
            asm volatile("s_waitcnt vmcnt(0)" ::: "memory");
            const unsigned og = xb_add(&bar[XB_TOP], 1u);
            const unsigned tg = og / nx;
            if (og + 1u == (tg + 1u) * nx) xb_add(&bar[XB_TOPGEN], 1u);
            else XB_SPIN(xb_ld(&bar[XB_TOPGEN]) == tg, bar);
            __builtin_amdgcn_fence(__ATOMIC_ACQUIRE, "agent");
            xb_add(&bar[XB_XGEN(b.x)], 1u);
            asm volatile("s_waitcnt vmcnt(0)" ::: "memory");
        } else {
            XB_SPIN(xb_ld(&bar[XB_XGEN(b.x)]) == gen, bar);
            __builtin_amdgcn_fence(__ATOMIC_ACQUIRE, "agent");
            asm volatile("s_waitcnt vmcnt(0)" ::: "memory");
        }
    }
    __syncthreads();
}
constexpr size_t WS_BAR = 65536;

__global__ void __launch_bounds__(512, 2) mega_fwd(Args a) {
    unsigned char* ap_ws = a.ws;
    __shared__ __attribute__((aligned(16))) unsigned char lds_raw[LDS_BYTES];
    LAS unsigned char* L = (LAS unsigned char*)lds_raw;
    cg::grid_group grid = cg::this_grid();
    volatile LAS unsigned* bst = (volatile LAS unsigned*)(L + LDS_BYTES - 16);
    if (threadIdx.x < 2) bst[threadIdx.x] = 0u;
    __syncthreads();
    (void)xcd_barrier_post((unsigned*)(ap_ws + WS_BAR), bst);
    const int st_hi = a.hi;
    for (int st = a.lo; st < st_hi; ++st) {
        const __attribute__((address_space(4))) Args* kp = (const __attribute__((address_space(4))) Args*)__builtin_amdgcn_kernarg_segment_ptr();
        asm volatile("" : "+s"(kp));
        if (st != 0 && st != 9 && st != 18 && (st - 1 - (st > 9 ? 9 : 0)) == 2) continue;
#define a (*kp)
        int tid = threadIdx.x; asm volatile("" : "+v"(tid));
        int bx = blockIdx.x; asm volatile("" : "+s"(bx));
        int G = gridDim.x; asm volatile("" : "+s"(G));
        const int lane = tid & 63, wave = __builtin_amdgcn_readfirstlane(tid >> 6);
        unsigned char* ws = a.ws;
        const float* x_in = a.in[0];
        float* lbv = (float*)(ws + WS_LBV);
        bf16_t* XB = (bf16_t*)(ws + WS_XB); float* SSP = (float*)(ws + WS_SSP);
        unsigned char* P = ws + WS_P;
        bf16_t *bU = (bf16_t*)(P + P_U), *bV = (bf16_t*)(P + P_V), *bQ = (bf16_t*)(P + P_Q), *bF = (bf16_t*)(P + P_F), *bI = (bf16_t*)(P + P_I), *bZO = (bf16_t*)(P + P_ZO),
               *bS = (bf16_t*)a.out  , *MIX = bQ  ;
        const unsigned char *bGA = P + P_GA, *bGB = P + P_GB;
        f32x2* bVST = (f32x2*)(P + P_VST); float* bD = (float*)(P + P_D);
        bf16_t* H1 = (bf16_t*)(ws + WS_H1);
        if (st >= 100) {
#ifdef DBG_OFF
            const bf16_t* src = (const bf16_t*)(ws + (size_t)DBG_OFF);
            for (size_t i = (size_t)bx * 512 + tid; i < (size_t)MTOT * DM; i += (size_t)G * 512) a.out[i] = bf2f(src[i]);
#endif
        } else if (st == 0 || st == 9) {
            const int wlayer = st == 0 ? 0 : 1;
            const int gw = bx * 8 + wave, NGW = G * 8;
            {
                LAS float* T = (LAS float*)L;
                f32x4 v[8];
                int it = bx;
                { const P0Item p = p0_decode(kp, it < P0_NITEMS ? it : P0_NITEMS - 1, wlayer); p0_load(p, v, wave, lane); }
                while (it < P0_NITEMS) {
                    const P0Item p = p0_decode(kp, it, wlayer);
#pragma unroll
                    for (int i = 0; i < 8; ++i)
#pragma unroll
                        for (int e = 0; e < 4; ++e) T[(wave * 8 + i) * 257 + lane * 4 + e] = v[i][e];
                    __syncthreads();
                    const int nx = it + G;
                    if (nx < P0_NITEMS) { const P0Item q = p0_decode(kp, nx, wlayer); p0_load(q, v, wave, lane); }
#pragma unroll
                    for (int j = 0; j < 4; ++j) {
                        const int q = tid + j * 512, n = q >> 3, c = q & 7;
                        const LAS float* t = T + (8 * c) * 257 + n;
                        u32x4 o; o.x = cvt_pk_bf16(t[0], t[257]); o.y = cvt_pk_bf16(t[2 * 257], t[3 * 257]); o.z = cvt_pk_bf16(t[4 * 257], t[5 * 257]); o.w = cvt_pk_bf16(t[6 * 257], t[7 * 257]);
                        *(u32x4*)(p.WT + (size_t)(p.n0 + n) * p.K + p.k0 + 8 * c) = o;
                    }
                    __syncthreads();
                    it = nx;
                }
            }
            const int m_end = st == 0 ? MTOT : 0;
            for (int m = gw; m < m_end; m += 2 * NGW) {
                const int m2 = m + NGW;
                const f32x4* xr = (const f32x4*)(x_in + (size_t)m * DM) + lane;
                const f32x4* xr2 = (const f32x4*)(x_in + (size_t)(m2 < MTOT ? m2 : m) * DM) + lane;
                f32x4 v[4], w[4]; float s = 0.f, s2 = 0.f;
#pragma unroll
                for (int j = 0; j < 4; ++j) { v[j] = __builtin_nontemporal_load(&xr[64 * j]); w[j] = __builtin_nontemporal_load(&xr2[64 * j]); }
#pragma unroll
                for (int j = 0; j < 4; ++j) { s += (v[j][0] * v[j][0] + v[j][1] * v[j][1]) + (v[j][2] * v[j][2] + v[j][3] * v[j][3]); s2 += (w[j][0] * w[j][0] + w[j][1] * w[j][1]) + (w[j][2] * w[j][2] + w[j][3] * w[j][3]); }
                s = wave_sum(s); s2 = wave_sum(s2);
                u32x2* o8 = (u32x2*)(XB + (size_t)m * DM) + lane;
#pragma unroll
                for (int j = 0; j < 4; ++j) o8[64 * j] = (u32x2){cvt_pk_bf16(v[j][0], v[j][1]), cvt_pk_bf16(v[j][2], v[j][3])};
                if (lane == 0) *(f32x4*)(SSP + (size_t)m * 4) = (f32x4){s, 0.f, 0.f, 0.f};
                if (m2 < MTOT) {
                    u32x2* o9 = (u32x2*)(XB + (size_t)m2 * DM) + lane;
#pragma unroll
                    for (int j = 0; j < 4; ++j) o9[64 * j] = (u32x2){cvt_pk_bf16(w[j][0], w[j][1]), cvt_pk_bf16(w[j][2], w[j][3])};
                    if (lane == 0) *(f32x4*)(SSP + (size_t)m2 * 4) = (f32x4){s2, 0.f, 0.f, 0.f};
                }
            }
            for (int i = bx * 512 + tid; i < (st == 0 ? 2048 : 0); i += G * 512) {
                const int c = i & 1023;
                lbv[i] = (i < 1024) ? 0.f : fast_rcp(1.0f + __expf(a.in[7][c] - a.in[7][1024 + c]));
            }
        } else if (st == 18) {
            const int gw = bx * 8 + wave, NGW = G * 8;
            const float* fn = a.in[15];
            f32x4 gq[4];
#pragma unroll
            for (int j = 0; j < 4; ++j) gq[j] = *((const f32x4*)fn + 64 * j + lane);
            for (int m0 = gw; m0 < MTOT; m0 += 4 * NGW) {
                u32x2 xv[4][4]; f32x4 pp[4];
#pragma unroll
                for (int r = 0; r < 4; ++r) {
                    const int m = m0 + r * NGW < MTOT ? m0 + r * NGW : m0;
                    const u32x2* xr = (const u32x2*)(XB + (size_t)m * DM) + lane;
#pragma unroll
                    for (int j = 0; j < 4; ++j) xv[r][j] = __builtin_nontemporal_load(&xr[64 * j]);
                    pp[r] = *(const f32x4*)(SSP + (size_t)m * 4);
                }
#pragma unroll
                for (int r = 0; r < 4; ++r) {
                    const int m = m0 + r * NGW;
                    if (m < MTOT) {
                        const float rstd = rstd4(pp[r]);
                        f32x4* orow = (f32x4*)(a.out + (size_t)m * DM) + lane;
#pragma unroll
                        for (int j = 0; j < 4; ++j) {
                            const f32x4 v = (f32x4){bf2f(xv[r][j].x & 0xffffu), bf2f(xv[r][j].x >> 16), bf2f(xv[r][j].y & 0xffffu), bf2f(xv[r][j].y >> 16)};
                            __builtin_nontemporal_store(v * rstd * gq[j], &orow[64 * j]);
                        }
                    }
                }
            }
        } else {
            const int l = st > 9 ? 1 : 0, k = st - 1 - 9 * l;
            unsigned char* wl = ws + WS_W;
            if (k < 5) {
                const int kind = k;
                if (kind == 0) {
                    pg8::Gemm g{XB, (const bf16_t*)(wl + WL_IN), MTOT, INC, DM};
                    pg8::StaticOrder S; S.init(MTOT, INC, G, bx);
                    EpiInProj E{SSP, P, bVST};

#ifndef NO_P1
                    for (int rep_ = 0; rep_ < DUP_P1; ++rep_) { pg8::gemm_phase<EpiInProj>(L, g, S, E, tid); asm volatile("s_waitcnt vmcnt(0)" ::: "memory"); __syncthreads(); }
#endif

                } else if (kind == 1) {
                    {
                        if (bx < 1024) gmlp_dma(L, bV, (bx >> 2) * 128, bx & 3, 0, tid);
                        int par = 0, gprev = -1;
                        for (int u = bx; u < 1024; u += G) {
                            const int g = u & 3, blk = u >> 2;
                            const int un = u + G; const bool hn = un < 1024;
                            gmlp_unit(L, bU, bV, bVST, a.in[4] + (size_t)(l * 4 + g) * 16384, a.in[5] + (l * 4 + g) * 128, a.in[2] + l * GW, a.in[3] + l * GW, blk * 128, g, tid,
                                      par, g != gprev, hn, (un >> 2) * 128, un & 3);
                            par ^= 1; gprev = g;
                        }
                    }
                    for (int sg = bx; sg < 256; sg += G) {
                        const int bh = sg >> 2, seg = sg & 3, hh = bh & 7, bl = bh >> 3, c0 = seg * 16;
                        const size_t toff0 = (size_t)(bl * SEQ + c0 * 64) * DM + hh * 128;
                        hgrn_b1_dma(L, bF + toff0, bI + toff0, tid);
                        asm volatile("s_waitcnt vmcnt(0)" ::: "memory");
                        __syncthreads();
                        float sst[8][4]; float cumdec = 1.f;
                        const float lb1 = lbv[l * 1024 + hh * 128 + (tid & 127)];
#pragma unroll
                        for (int vt = 0; vt < 8; ++vt)
#pragma unroll
                            for (int i = 0; i < 4; ++i) sst[vt][i] = 0.f;
                        for (int i = 0; i < 16; ++i) {
                            const int u = bh * 64 + c0 + i; const bool hn = i < 15;
                            const size_t toffn = toff0 + (size_t)(hn ? i + 1 : i) * 64 * DM;
                            hgrn_b1_unit(L, bS + (size_t)u * 16384, bD + (size_t)u * 128, sst, cumdec, lb1, tid, hn, bF + toffn, bI + toffn);
                        }
                        {
                            const int wid = tid >> 6, fr = tid & 15, fq = (tid & 63) >> 4;
                            float* sb = (float*)(P + P_SEGB) + (size_t)sg * 16384;
#pragma unroll
                            for (int vt = 0; vt < 8; ++vt) *(f32x4*)(sb + (size_t)(16 * vt + fr) * 128 + 16 * wid + 4 * fq) = (f32x4){sst[vt][0], sst[vt][1], sst[vt][2], sst[vt][3]};
                            if (tid < 128) ((float*)(P + P_SEGA))[(size_t)sg * 128 + tid] = cumdec;
                        }
                    }
                } else if (kind == 2) {
                } else if (kind == 3) {
                    for (int sg = bx; sg < 256; sg += G) {
                        const int wid = tid >> 6, fr = tid & 15, fq = (tid & 63) >> 4;
                        const int bh = sg >> 2, seg = sg & 3, hh = bh & 7, bl = bh >> 3, c0 = seg * 16;
                        const size_t toff0 = (size_t)(bl * SEQ + c0 * 64) * DM + hh * 128;
                        hgrn_b3_dma(L, bQ + toff0, bF + toff0, tid);
                        hgrn_b3_dma_v(L, bI + toff0, tid);
                        f32x4 sq0[4], sq1[4];
                        {
                            float z_ = 0.f; asm volatile("" : "+v"(z_));
#pragma unroll
                            for (int ks = 0; ks < 4; ++ks) { sq0[ks] = (f32x4){z_, z_, z_, z_}; sq1[ks] = (f32x4){z_, z_, z_, z_}; }
                            for (int j = 0; j < seg; ++j) {
                                const float* sbj = (const float*)(P + P_SEGB) + (size_t)(bh * 4 + j) * 16384 + (size_t)(16 * wid + fr) * 128 + fq * 8;
                                const float* saj = (const float*)(P + P_SEGA) + (size_t)(bh * 4 + j) * 128 + fq * 8;
#pragma unroll
                                for (int ks = 0; ks < 4; ++ks) {
                                    sq0[ks] = *(const f32x4*)(saj + ks * 32) * sq0[ks] + *(const f32x4*)(sbj + ks * 32);
                                    sq1[ks] = *(const f32x4*)(saj + ks * 32 + 4) * sq1[ks] + *(const f32x4*)(sbj + ks * 32 + 4);
                                }
                            }
                        }
                        const float lb3 = lbv[l * 1024 + hh * 128 + (tid & 127)];
                        asm volatile("s_waitcnt vmcnt(0)" ::: "memory");
                        __syncthreads();
                        for (int i = 0; i < 16; ++i) {
                            const int u = bh * 64 + c0 + i; const bool hn = i < 15;
                            const size_t toff = toff0 + (size_t)i * 64 * DM, toffn = toff0 + (size_t)(hn ? i + 1 : i) * 64 * DM;
                            hgrn_b3_unit(L, bI + toff, bZO + toff, bS + (size_t)u * 16384, sq0, sq1, bD + (size_t)u * 128, lb3, a.in[8] + l * 128, tid, hn, bQ + toffn, bF + toffn, bI + toffn);
                        }
                    }
                } else {
                    for (int pass = 0; pass < 2; ++pass) {
                        pg8::Gemm g{pass == 0 ? bU : bI, (const bf16_t*)(wl + (pass == 0 ? WL_A : WL_B)), MTOT, DM, pass == 0 ? GW : DM};
                        pg8::StaticOrder S; S.init(MTOT, DM, G, bx);
                        EpiMix E{pass == 0 ? bGA : bGB, MIX, pass == 0 ? 1 : 0};

#ifndef NO_P3
                        pg8::gemm_phase<EpiMix>(L, g, S, E, tid);
#endif

                    }
                }
            } else if (k == 5 || k == 7) {
                pg8::Gemm g{k == 5 ? MIX : H1, (const bf16_t*)(wl + (k == 5 ? WL_O : WL_2)), MTOT, DM, k == 5 ? DM : DFF};
                pg8::StaticOrder S; S.init(MTOT, DM, G, bx);
                EpiResid E{XB, SSP, L + 131072};

#ifndef NO_P4
                pg8::gemm_phase<EpiResid>(L, g, S, E, tid);
#endif

            } else {
                pg8::Gemm g{XB, (const bf16_t*)(wl + WL_1), MTOT, DFF, DM};
                pg8::StaticOrder S; S.init(MTOT, DFF, G, bx);
                EpiFF1 E{SSP, H1};

#ifndef NO_P5
                pg8::gemm_phase<EpiFF1>(L, g, S, E, tid);
#endif

            }
        }
#undef a
        if (st + 1 < st_hi) {
            if (st_hi > 1000) grid.sync();
            else { XcdBarrier xbar; xbar.bar = (unsigned*)(kp->ws + WS_BAR); xbar.x = xb_xcc_id(); xbar.st = (volatile LAS unsigned*)(L + LDS_BYTES - 16); xcd_barrier(xbar); }
        }
    }
}

extern "C" void kernel_launch(void* const* d_in, const int* in_sizes, int n_in, void* d_out, int out_size, void* d_ws, size_t ws_size, hipStream_t stream) {
    static int grid = 0;
    if (grid == 0) {
        if (n_in != 16 || out_size != MTOT * DM || ws_size < WS_END) { fprintf(stderr, "kernel_launch: unexpected shapes / workspace (%d inputs, out %d, ws %zu < %zu)\n", n_in, out_size, ws_size, (size_t)WS_END); grid = -1; return; }
        int dev = 0, cus = 0, per_cu = 0;
        hipGetDevice(&dev); hipDeviceGetAttribute(&cus, hipDeviceAttributeMultiprocessorCount, dev);
        hipOccupancyMaxActiveBlocksPerMultiprocessor(&per_cu, (const void*)mega_fwd, 512, 0);
        (void)hipGetLastError();
        if (per_cu < 1) per_cu = 1;
        grid = cus * 1;
        if (grid <= 0) grid = 256;
    }
    if (grid < 0) return;
    (void)hipMemsetAsync((char*)d_ws + WS_BAR, 0, 16384, stream);
    Args a{};
    for (int i = 0; i < 16; ++i) a.in[i] = (const float*)d_in[i];
    a.out = (float*)d_out; a.ws = (unsigned char*)d_ws;
#if MK_MULTI
#ifdef DBG_STOP
    for (int st = 0; st < DBG_STOP; ++st) { a.lo = st; a.hi = st + 1; hipLaunchKernelGGL(mega_fwd, dim3(grid), dim3(512), 0, stream, a); }
    a.lo = 100; a.hi = 101; hipLaunchKernelGGL(mega_fwd, dim3(grid), dim3(512), 0, stream, a);
#else
    for (int st = 0; st < 19; ++st) { a.lo = st; a.hi = st + 1; hipLaunchKernelGGL(mega_fwd, dim3(grid), dim3(512), 0, stream, a); }
#endif
#else
    a.lo = 0; a.hi = 19;
    void* args[] = {&a};
    hipError_t e = hipLaunchCooperativeKernel((const void*)mega_fwd, dim3(grid), dim3(512), args, 0, stream);
    if (e != hipSuccess) fprintf(stderr, "cooperative launch failed: %s (grid %d)\n", hipGetErrorString(e), grid);
#endif
}
```

```cpp
#include <hip/hip_runtime.h>
#include <hip/hip_cooperative_groups.h>
#include <cstdio>
#include <cstdint>
namespace cg = cooperative_groups;
#define MK_MULTI 0
#ifndef DUP_B1
#define DUP_B1 1
#endif
#ifndef DUP_P1
#define DUP_P1 1
#endif

#define LAS __attribute__((address_space(3)))
typedef unsigned short bf16_t;
typedef short bf16x8 __attribute__((ext_vector_type(8)));
typedef float f32x4 __attribute__((ext_vector_type(4)));
typedef float f32x2 __attribute__((ext_vector_type(2)));
typedef unsigned u32x4 __attribute__((ext_vector_type(4)));
typedef unsigned u32x2 __attribute__((ext_vector_type(2)));

constexpr int DM = 1024, BATCH = 8, SEQ = 4096, MTOT = BATCH * SEQ;
constexpr int INC = 7168, DFF = 4096, GW = 512;
constexpr float EPS = 1e-6f;

__device__ __forceinline__ float bf2f(unsigned v) { return __uint_as_float(v << 16); }
typedef __bf16 bf16x2_t __attribute__((ext_vector_type(2)));
__device__ __forceinline__ unsigned cvt_pk_bf16(float lo, float hi) { f32x2 v = {lo, hi}; bf16x2_t b = __builtin_convertvector(v, bf16x2_t); return __builtin_bit_cast(unsigned, b); }
__device__ __forceinline__ float fast_rcp(float x) { return __builtin_amdgcn_rcpf(x); }
__device__ __forceinline__ float sigmoidf_(float x) { return fast_rcp(1.0f + __expf(-x)); }
__device__ __forceinline__ float siluf_(float x) { return x * sigmoidf_(x); }
__device__ __forceinline__ f32x2 gelu_pk(f32x2 v) {
    const f32x2 av = __builtin_elementwise_abs(v), d = av * 0.2316418882f + 1.0f;
    f32x2 t; t.x = __builtin_amdgcn_rcpf(d.x); t.y = __builtin_amdgcn_rcpf(d.y);
    f32x2 q = t * 0.5307027145f + (-0.7265760135f); q = q * t + 0.7107068705f; q = q * t + (-0.142248368f); q = q * t + 0.127414796f; q = q * t;
    const f32x2 s = (v * v) * (-0.72134752044f);
    f32x2 e; e.x = __builtin_amdgcn_exp2f(s.x); e.y = __builtin_amdgcn_exp2f(s.y);
    const f32x2 m = v * (q * e), r = v - m;
    f32x2 o; o.x = v.x < 0.f ? m.x : r.x; o.y = v.y < 0.f ? m.y : r.y; return o;
}
__device__ __forceinline__ float wave_sum(float v) {
#pragma unroll
    for (int o = 1; o < 64; o <<= 1) v += __shfl_xor(v, o);
    return v;
}

namespace pg8 {
constexpr int BM = 256, BK = 64, HALF = 128, HTB = HALF * BK * 2, STAGE_BYTES = 8 * HTB, NXCD = 8, WGM = 8;
__host__ __device__ __forceinline__ int lds_byte(int r, int c) { const int st = (r >> 4) * 2 + (c >> 5), rr = r & 15, cc = c & 31, ob = rr * 64 + cc * 2; return st * 1024 + (ob ^ (((ob >> 9) & 1) << 5)); }
__host__ __device__ __forceinline__ void stage_rc(int b, int& R, int& C) { const int st = b / 1024, sb = b % 1024, swz = sb ^ (((sb >> 9) & 1) << 5); R = (st >> 1) * 16 + swz / 64; C = (st & 1) * 32 + (swz % 64) / 2; }
__host__ __device__ __forceinline__ int perm32(int rho) { const int n = rho >> 4, i = rho & 15; return 8 * (i >> 2) + 4 * n + (i & 3); }
struct Unit { int pm, pn; };
struct Gemm { const bf16_t* A; const bf16_t* Bt; int M, N, K; };
struct StaticOrder {
    int nM, nN, nwg, G, c;
    __device__ void init(int M, int N, int G_, int c_) { nM = M / BM; nN = N / BM; nwg = nM * nN; G = G_; c = c_; }
    __device__ bool next(int i, Unit& u) const {
        const long L = (long)i * G + c; if (L >= nwg) return false;
        int wgid = (int)L; { const int q = nwg / NXCD, r = nwg % NXCD, xcd = wgid % NXCD, off = wgid / NXCD; wgid = (xcd < r ? xcd * (q + 1) : r * (q + 1) + (xcd - r) * q) + off; }
        const int nig = WGM * nN, gid = wgid / nig, fm = gid * WGM, gsz = (nM - fm) < WGM ? (nM - fm) : WGM;
        u.pm = fm + ((wgid % nig) % gsz); u.pn = (wgid % nig) / gsz; return true;
    }
};
template <class Epi>
__device__ __forceinline__ void gemm_phase(LAS unsigned char* lds, const Gemm g, const StaticOrder& S, const Epi& E, const int tid) {
    const int wid = __builtin_amdgcn_readfirstlane(tid >> 6), lane = tid & 63, wr = wid >> 2, wc = wid & 3, fr = lane & 15, fq = lane >> 4;
    const int K = g.K, nt = K / BK;
    unsigned voffA[2], voffB[2];
#pragma unroll
    for (int i = 0; i < 2; ++i) { int R, C; stage_rc(tid * 16 + i * 8192, R, C); const int Rb = (R & ~31) + perm32(R & 31);
        voffA[i] = (unsigned)(R * K + C) * 2u; voffB[i] = (unsigned)(Rb * K + C) * 2u; }
    const size_t kstep = (size_t)(BK * 2);
    const size_t hstep = (size_t)HALF * K * 2;
    const size_t tstep = 2 * hstep;
    const unsigned ldsw = (unsigned)wid * 1024u;
    const int aoff = lds_byte(wr * 64 + fr, fq * 8), boff = lds_byte(wc * 32 + fr, fq * 8);
#define PG8_SA(b, h) (((b) * 2 + (h)) * HTB)
#define PG8_SB(b, h) ((4 + (b) * 2 + (h)) * HTB)
#define PG8_STAGE(bufoff, gbase, voff) do { _Pragma("unroll") for (int _i = 0; _i < 2; ++_i) \
        __builtin_amdgcn_global_load_lds((const unsigned*)((const char*)(gbase) + (voff)[_i]), (LAS unsigned*)(lds + (bufoff) + ldsw + _i * 8192), 16, 0, 0); } while (0)
#define PG8_LDA(dst, b, h) do { _Pragma("unroll") for (int m = 0; m < 4; ++m) _Pragma("unroll") for (int k = 0; k < 2; ++k) dst[m][k] = *(const LAS bf16x8*)(lds + PG8_SA(b, h) + aoff + m * 2048 + k * 1024); } while (0)
#define PG8_LDB(dst, b, h) do { _Pragma("unroll") for (int n = 0; n < 2; ++n) _Pragma("unroll") for (int k = 0; k < 2; ++k) dst[n][k] = *(const LAS bf16x8*)(lds + PG8_SB(b, h) + boff + n * 2048 + k * 1024); } while (0)
#define PG8_MMA(ai, bj, At, Bt) do { __builtin_amdgcn_s_setprio(1); _Pragma("unroll") for (int m = 0; m < 4; ++m) _Pragma("unroll") for (int n = 0; n < 2; ++n) _Pragma("unroll") for (int k = 0; k < 2; ++k) \
        acc[ai][bj][m][n] = __builtin_amdgcn_mfma_f32_16x16x32_bf16(Bt[n][k], At[m][k], acc[ai][bj][m][n], 0, 0, 0); __builtin_amdgcn_s_setprio(0); } while (0)
#define PG8_WAIT_V(n) asm volatile("s_waitcnt vmcnt(" #n ")" ::: "memory")
#define PG8_WAIT_L(n) asm volatile("s_waitcnt lgkmcnt(" #n ")" ::: "memory")
#define PG8_BAR __builtin_amdgcn_s_barrier()
#define PG8_SCHED __builtin_amdgcn_sched_barrier(0)
    Unit cur, nxt; int ui = 0;
    if (!S.next(0, cur)) return;
    f32x4 acc[2][2][4][2];
    E.init(acc, cur, wr, wc, fr, fq);
    bf16x8 At[4][2], B0[2][2], B1[2][2];
    const char* cA = (const char*)g.A + (size_t)cur.pm * tstep; const char* cB = (const char*)g.Bt + (size_t)cur.pn * tstep;
    PG8_STAGE(PG8_SB(0, 0), cB, voffB); PG8_STAGE(PG8_SB(0, 1), cB + hstep, voffB); PG8_STAGE(PG8_SA(0, 0), cA, voffA); PG8_STAGE(PG8_SA(0, 1), cA + hstep, voffA);
    if (wr == 1) PG8_BAR;
    PG8_WAIT_V(2); PG8_BAR;
    PG8_STAGE(PG8_SB(1, 0), cB + kstep, voffB); PG8_STAGE(PG8_SA(1, 0), cA + kstep, voffA); PG8_STAGE(PG8_SB(1, 1), cB + hstep + kstep, voffB);
    PG8_WAIT_V(6); PG8_BAR;
    for (;;) {
        const bool has_next = S.next(ui + 1, nxt);
        const char* nA = has_next ? (const char*)g.A + (size_t)nxt.pm * tstep : cA; const char* nB = has_next ? (const char*)g.Bt + (size_t)nxt.pn * tstep : cB;
        for (int t = 0; t < nt; t += 2) {
            const bool last = (t == nt - 2);
            const char* a1 = cA + (size_t)(t + 1) * kstep;
            const char* a2 = last ? nA : cA + (size_t)(t + 2) * kstep; const char* b2 = last ? nB : cB + (size_t)(t + 2) * kstep;
            const char* a3 = a2 + kstep; const char* b3 = b2 + kstep;
            PG8_LDB(B0, 0, 0); PG8_LDB(B1, 0, 1); PG8_SCHED; PG8_LDA(At, 0, 0); PG8_STAGE(PG8_SA(1, 1), a1 + hstep, voffA);
            PG8_WAIT_V(8); PG8_WAIT_L(0); PG8_BAR; PG8_MMA(0, 0, At, B0); PG8_MMA(0, 1, At, B1); PG8_BAR; PG8_SCHED;
            PG8_LDA(At, 0, 1); PG8_STAGE(PG8_SB(0, 0), b2, voffB); PG8_STAGE(PG8_SB(0, 1), b2 + hstep, voffB); PG8_STAGE(PG8_SA(0, 0), a2, voffA);
            PG8_WAIT_V(8); PG8_WAIT_L(0); PG8_BAR; PG8_MMA(1, 0, At, B0); PG8_MMA(1, 1, At, B1); PG8_BAR; PG8_SCHED;
            PG8_LDB(B0, 1, 0); PG8_LDB(B1, 1, 1); PG8_SCHED; PG8_LDA(At, 1, 0); PG8_STAGE(PG8_SA(0, 1), a2 + hstep, voffA);
            PG8_WAIT_V(8); PG8_WAIT_L(0); PG8_BAR; PG8_MMA(0, 0, At, B0); PG8_MMA(0, 1, At, B1); PG8_BAR; PG8_SCHED;
            PG8_LDA(At, 1, 1); PG8_STAGE(PG8_SB(1, 0), b3, voffB); PG8_STAGE(PG8_SB(1, 1), b3 + hstep, voffB); PG8_STAGE(PG8_SA(1, 0), a3, voffA);
            PG8_WAIT_V(8); PG8_WAIT_L(0); PG8_BAR; PG8_MMA(1, 0, At, B0); PG8_MMA(1, 1, At, B1); PG8_BAR; PG8_SCHED;
        }
        if (wr == 0) PG8_BAR;
        E(acc, cur, wr, wc, fr, fq);
        if (!has_next) break;
        E.init(acc, nxt, wr, wc, fr, fq);
        cur = nxt; cA = nA; cB = nB; ++ui;
        if (wr == 1) PG8_BAR;
    }
    PG8_WAIT_V(0);
    PG8_BAR;
#undef PG8_SA
#undef PG8_SB
#undef PG8_STAGE
#undef PG8_LDA
#undef PG8_LDB
#undef PG8_MMA
#undef PG8_WAIT_V
#undef PG8_WAIT_L
#undef PG8_BAR
#undef PG8_SCHED
}
}
using pg8::Unit;

constexpr size_t WS_LBV = 0;
constexpr size_t WS_W = 1u << 20;
constexpr size_t WL_IN = 0, WL_A = WL_IN + (size_t)INC * DM * 2, WL_B = WL_A + (size_t)DM * GW * 2, WL_O = WL_B + (size_t)DM * DM * 2,
                 WL_1 = WL_O + (size_t)DM * DM * 2, WL_2 = WL_1 + (size_t)DFF * DM * 2, WL_SIZE = WL_2 + (size_t)DM * DFF * 2;
constexpr size_t WS_XB = WS_W + WL_SIZE;
constexpr size_t WS_SSP = WS_XB + (size_t)MTOT * DM * 2;
constexpr size_t WS_P = WS_SSP + (size_t)MTOT * 16 * 4;
constexpr size_t P_U = 0, P_V = P_U + (size_t)MTOT * GW * 2, P_Q = P_V + (size_t)MTOT * GW * 2, P_F = P_Q + (size_t)MTOT * DM * 2, P_I = P_F + (size_t)MTOT * DM * 2,
                 P_ZO = P_I + (size_t)MTOT * DM * 2, P_GA = P_ZO + (size_t)MTOT * DM * 2, P_GB = P_GA + (size_t)MTOT * DM  , P_VST = P_GB + (size_t)MTOT * DM,
                 P_D = P_VST + (size_t)MTOT * 8 * 8, P_SEGB = P_D + (size_t)4096 * 128 * 4, P_SEGA = P_SEGB + (size_t)256 * 16384 * 4, P_END = P_SEGA + (size_t)256 * 128 * 4;
constexpr size_t WS_H1 = WS_P;
constexpr size_t WS_END = WS_P + (P_END > (size_t)MTOT * DFF * 2 ? P_END : (size_t)MTOT * DFF * 2);
static_assert(WS_END <= 536870912ull, "workspace map exceeds 512 MiB");

__device__ __forceinline__ float rstd4(const f32x4 p) { return rsqrtf(((p[0] + p[1]) + (p[2] + p[3])) * (1.0f / DM) + EPS); }

struct EpiInProj {
    const float* ssp; unsigned char* P; f32x2* vst;
    __device__ __forceinline__ void init(f32x4 (&acc)[2][2][4][2], const Unit&, int, int, int, int) const {
#pragma unroll
        for (int a_ = 0; a_ < 2; ++a_)
#pragma unroll
            for (int b_ = 0; b_ < 2; ++b_)
#pragma unroll
                for (int m_ = 0; m_ < 4; ++m_)
#pragma unroll
                    for (int n_ = 0; n_ < 2; ++n_) acc[a_][b_][m_][n_] = (f32x4){0.f, 0.f, 0.f, 0.f};
    }
    __device__ __forceinline__ void operator()(const f32x4 (&acc)[2][2][4][2], const Unit& u, int wr, int wc, int fr, int fq) const {
        const int pn = u.pn; size_t boff; int ldc, colt, act;
        if (pn < 2) { boff = P_U; ldc = GW; colt = pn * 256; act = 1; }
        else if (pn < 4) { boff = P_V; ldc = GW; colt = (pn - 2) * 256; act = 2; }
        else if (pn < 8) { boff = P_Q; ldc = DM; colt = (pn - 4) * 256; act = 3; }
        else if (pn < 12) { boff = P_F; ldc = DM; colt = (pn - 8) * 256; act = 0; }
        else if (pn < 16) { boff = P_I; ldc = DM; colt = (pn - 12) * 256; act = 0; }
        else if (pn < 20) { boff = P_ZO; ldc = DM; colt = (pn - 16) * 256; act = 3; }
        else if (pn < 24) { boff = P_GA; ldc = DM / 2; colt = (pn - 20) * 256; act = 4; }
        else { boff = P_GB; ldc = DM / 2; colt = (pn - 24) * 256; act = 4; }
        bf16_t* base = (bf16_t*)(P + boff);
        const int col0 = colt + wc * 32 + 8 * fq;
        f32x4 pr[2][4];
#pragma unroll
        for (int ai = 0; ai < 2; ++ai)
#pragma unroll
            for (int m = 0; m < 4; ++m) pr[ai][m] = *(const f32x4*)(ssp + (size_t)(u.pm * 256 + ai * 128 + wr * 64 + m * 16 + fr) * 4);
#pragma unroll
        for (int ai = 0; ai < 2; ++ai)
#pragma unroll
            for (int m = 0; m < 4; ++m) {
                const int row = u.pm * 256 + ai * 128 + wr * 64 + m * 16 + fr;
                const float rs = rstd4(pr[ai][m]);
                bf16_t* rowp = base + (size_t)row * ldc + col0;
                float s1 = 0.f, s2 = 0.f;
#pragma unroll
                for (int bj = 0; bj < 2; ++bj) {
                    f32x4 v0 = acc[ai][bj][m][0] * rs, v1 = acc[ai][bj][m][1] * rs;
                    if (act == 1 || act == 2) {
                        f32x2 a = gelu_pk((f32x2){v0[0], v0[1]}), b = gelu_pk((f32x2){v0[2], v0[3]}), c = gelu_pk((f32x2){v1[0], v1[1]}), d = gelu_pk((f32x2){v1[2], v1[3]});
                        v0 = (f32x4){a.x, a.y, b.x, b.y}; v1 = (f32x4){c.x, c.y, d.x, d.y};
                        if (act == 2) {
                            s1 += ((v0[0] + v0[1]) + (v0[2] + v0[3])) + ((v1[0] + v1[1]) + (v1[2] + v1[3]));
                            s2 += ((v0[0] * v0[0] + v0[1] * v0[1]) + (v0[2] * v0[2] + v0[3] * v0[3])) + ((v1[0] * v1[0] + v1[1] * v1[1]) + (v1[2] * v1[2] + v1[3] * v1[3]));
                        }
                    } else if (act == 3) {
#pragma unroll
                        for (int e = 0; e < 4; ++e) { v0[e] = siluf_(v0[e]); v1[e] = siluf_(v1[e]); }
                    } else if (act == 4) {
                        unsigned q0 = 0u, q1 = 0u;
#pragma unroll
                        for (int e = 0; e < 4; ++e) { q0 |= (unsigned)(sigmoidf_(v0[e]) * 255.0f + 0.5f) << (8 * e); q1 |= (unsigned)(sigmoidf_(v1[e]) * 255.0f + 0.5f) << (8 * e); }
                        *(u32x2*)((unsigned char*)base + (size_t)row * DM + col0 + bj * 128) = (u32x2){q0, q1};
                        continue;
                    }
                    u32x4 w; w.x = cvt_pk_bf16(v0[0], v0[1]); w.y = cvt_pk_bf16(v0[2], v0[3]); w.z = cvt_pk_bf16(v1[0], v1[1]); w.w = cvt_pk_bf16(v1[2], v1[3]);
                    *(u32x4*)(rowp + bj * 128) = w;
                }
                if (act == 2) {
                    s1 += __shfl_xor(s1, 16); s1 += __shfl_xor(s1, 32); s2 += __shfl_xor(s2, 16); s2 += __shfl_xor(s2, 32);
                    if (fq == 0) vst[(size_t)row * 8 + (pn - 2) * 4 + wc] = (f32x2){s1, s2};
                }
            }
    }
};
struct EpiMix {
    const unsigned char* G; bf16_t* MIX; int first;
    __device__ __forceinline__ void init(f32x4 (&acc)[2][2][4][2], const Unit&, int, int, int, int) const {
#pragma unroll
        for (int a_ = 0; a_ < 2; ++a_)
#pragma unroll
            for (int b_ = 0; b_ < 2; ++b_)
#pragma unroll
                for (int m_ = 0; m_ < 4; ++m_)
#pragma unroll
                    for (int n_ = 0; n_ < 2; ++n_) acc[a_][b_][m_][n_] = (f32x4){0.f, 0.f, 0.f, 0.f};
    }
    __device__ __forceinline__ void operator()(const f32x4 (&acc)[2][2][4][2], const Unit& u, int wr, int wc, int fr, int fq) const {
        const int col0 = u.pn * 256 + wc * 32 + 8 * fq;
        u32x2 gq[2][4][2];
#pragma unroll
        for (int ai = 0; ai < 2; ++ai)
#pragma unroll
            for (int m = 0; m < 4; ++m) {
                const size_t off = (size_t)(u.pm * 256 + ai * 128 + wr * 64 + m * 16 + fr) * DM + col0;
#pragma unroll
                for (int bj = 0; bj < 2; ++bj) gq[ai][m][bj] = *(const u32x2*)(G + off + bj * 128);
            }
        u32x4 mq[1][4][2];
#pragma unroll
        for (int m = 0; m < 4; ++m) {
            const size_t off = (size_t)(u.pm * 256 + wr * 64 + m * 16 + fr) * DM + col0;
#pragma unroll
            for (int bj = 0; bj < 2; ++bj) mq[0][m][bj] = first ? (u32x4){0u, 0u, 0u, 0u} : *(const u32x4*)(MIX + off + bj * 128);
        }
#pragma unroll
        for (int ai = 0; ai < 2; ++ai) {
            if (ai == 1) {
#pragma unroll
                for (int m = 0; m < 4; ++m) {
                    const size_t off = (size_t)(u.pm * 256 + 128 + wr * 64 + m * 16 + fr) * DM + col0;
#pragma unroll
                    for (int bj = 0; bj < 2; ++bj) mq[0][m][bj] = first ? (u32x4){0u, 0u, 0u, 0u} : *(const u32x4*)(MIX + off + bj * 128);
                }
            }
#pragma unroll
            for (int m = 0; m < 4; ++m) {
                const size_t off = (size_t)(u.pm * 256 + ai * 128 + wr * 64 + m * 16 + fr) * DM + col0;
#pragma unroll
                for (int bj = 0; bj < 2; ++bj) {
                    const u32x2 g2 = gq[ai][m][bj]; const u32x4 m4 = mq[0][m][bj];
                    constexpr float IG = 1.0f / 255.0f;
                    f32x4 v0 = acc[ai][bj][m][0], v1 = acc[ai][bj][m][1];
                    v0[0] = v0[0] * ((float)(g2.x & 255u) * IG) + bf2f(m4.x & 0xffffu); v0[1] = v0[1] * ((float)((g2.x >> 8) & 255u) * IG) + bf2f(m4.x >> 16);
                    v0[2] = v0[2] * ((float)((g2.x >> 16) & 255u) * IG) + bf2f(m4.y & 0xffffu); v0[3] = v0[3] * ((float)(g2.x >> 24) * IG) + bf2f(m4.y >> 16);
                    v1[0] = v1[0] * ((float)(g2.y & 255u) * IG) + bf2f(m4.z & 0xffffu); v1[1] = v1[1] * ((float)((g2.y >> 8) & 255u) * IG) + bf2f(m4.z >> 16);
                    v1[2] = v1[2] * ((float)((g2.y >> 16) & 255u) * IG) + bf2f(m4.w & 0xffffu); v1[3] = v1[3] * ((float)(g2.y >> 24) * IG) + bf2f(m4.w >> 16);
                    u32x4 w; w.x = cvt_pk_bf16(v0[0], v0[1]); w.y = cvt_pk_bf16(v0[2], v0[3]); w.z = cvt_pk_bf16(v1[0], v1[1]); w.w = cvt_pk_bf16(v1[2], v1[3]);
                    *(u32x4*)(MIX + off + bj * 128) = w;
                }
            }
        }
    }
};
struct EpiResid {
    bf16_t* XB; float* ssp; LAS unsigned char* red;
    __device__ __forceinline__ void init(f32x4 (&acc)[2][2][4][2], const Unit& u, int wr, int wc, int fr, int fq) const {
        const int col0 = u.pn * 256 + wc * 32 + 8 * fq;
#pragma unroll
        for (int ai = 0; ai < 2; ++ai)
#pragma unroll
            for (int m = 0; m < 4; ++m) {
                const size_t off = (size_t)(u.pm * 256 + ai * 128 + wr * 64 + m * 16 + fr) * DM + col0;
#pragma unroll
                for (int bj = 0; bj < 2; ++bj) {
                    const u32x4 q = *(const u32x4*)(XB + off + bj * 128);
                    acc[ai][bj][m][0] = (f32x4){bf2f(q.x & 0xffffu), bf2f(q.x >> 16), bf2f(q.y & 0xffffu), bf2f(q.y >> 16)};
                    acc[ai][bj][m][1] = (f32x4){bf2f(q.z & 0xffffu), bf2f(q.z >> 16), bf2f(q.w & 0xffffu), bf2f(q.w >> 16)};
                }
            }
    }
    __device__ __forceinline__ void operator()(const f32x4 (&acc)[2][2][4][2], const Unit& u, int wr, int wc, int fr, int fq) const {
        const int col0 = u.pn * 256 + wc * 32 + 8 * fq;
#pragma unroll
        for (int ai = 0; ai < 2; ++ai)
#pragma unroll
            for (int m = 0; m < 4; ++m) {
                const int rl = ai * 128 + wr * 64 + m * 16 + fr;
                const size_t off = (size_t)(u.pm * 256 + rl) * DM + col0;
                float ss = 0.f;
#pragma unroll
                for (int bj = 0; bj < 2; ++bj) {
                    const f32x4 v0 = acc[ai][bj][m][0], v1 = acc[ai][bj][m][1];
                    ss += ((v0[0] * v0[0] + v0[1] * v0[1]) + (v0[2] * v0[2] + v0[3] * v0[3])) + ((v1[0] * v1[0] + v1[1] * v1[1]) + (v1[2] * v1[2] + v1[3] * v1[3]));
                    u32x4 w; w.x = cvt_pk_bf16(v0[0], v0[1]); w.y = cvt_pk_bf16(v0[2], v0[3]); w.z = cvt_pk_bf16(v1[0], v1[1]); w.w = cvt_pk_bf16(v1[2], v1[3]);
                    *(u32x4*)(XB + off + bj * 128) = w;
                }
                ss += __shfl_xor(ss, 16); ss += __shfl_xor(ss, 32);
                if (fq == 0) *(LAS float*)(red + (rl * 4 + wc) * 4) = ss;
            }
        asm volatile("s_waitcnt lgkmcnt(0)" ::: "memory"); __builtin_amdgcn_s_barrier(); asm volatile("" ::: "memory");
        const int t = (wr * 4 + wc) * 64 + fq * 16 + fr;
        if (t < 256) { const f32x4 p = *(const LAS f32x4*)(red + t * 16); ssp[(size_t)(u.pm * 256 + t) * 4 + u.pn] = (p[0] + p[1]) + (p[2] + p[3]); }
    }
};
struct EpiFF1 {
    const float* ssp; bf16_t* H;
    __device__ __forceinline__ void init(f32x4 (&acc)[2][2][4][2], const Unit&, int, int, int, int) const {
#pragma unroll
        for (int a_ = 0; a_ < 2; ++a_)
#pragma unroll
            for (int b_ = 0; b_ < 2; ++b_)
#pragma unroll
                for (int m_ = 0; m_ < 4; ++m_)
#pragma unroll
                    for (int n_ = 0; n_ < 2; ++n_) acc[a_][b_][m_][n_] = (f32x4){0.f, 0.f, 0.f, 0.f};
    }
    __device__ __forceinline__ void operator()(const f32x4 (&acc)[2][2][4][2], const Unit& u, int wr, int wc, int fr, int fq) const {
        const int col0 = u.pn * 256 + wc * 32 + 8 * fq;
        f32x4 pr[2][4];
#pragma unroll
        for (int ai = 0; ai < 2; ++ai)
#pragma unroll
            for (int m = 0; m < 4; ++m) pr[ai][m] = *(const f32x4*)(ssp + (size_t)(u.pm * 256 + ai * 128 + wr * 64 + m * 16 + fr) * 4);
#pragma unroll
        for (int ai = 0; ai < 2; ++ai)
#pragma unroll
            for (int m = 0; m < 4; ++m) {
                const int row = u.pm * 256 + ai * 128 + wr * 64 + m * 16 + fr;
                const float rs = rstd4(pr[ai][m]);
                bf16_t* rowp = H + (size_t)row * DFF + col0;
#pragma unroll
                for (int bj = 0; bj < 2; ++bj) {
                    f32x4 v0 = acc[ai][bj][m][0], v1 = acc[ai][bj][m][1];
#pragma unroll
                    for (int e = 0; e < 4; ++e) { const float a = fmaxf(v0[e], 0.f), b = fmaxf(v1[e], 0.f); v0[e] = a * a; v1[e] = b * b; }
                    v0 = v0 * (rs * rs); v1 = v1 * (rs * rs);
                    u32x4 w; w.x = cvt_pk_bf16(v0[0], v0[1]); w.y = cvt_pk_bf16(v0[2], v0[3]); w.z = cvt_pk_bf16(v1[0], v1[1]); w.w = cvt_pk_bf16(v1[2], v1[3]);
                    *(u32x4*)(rowp + bj * 128) = w;
                }
            }
    }
};

constexpr int LDS_BYTES = 147456;

struct Args { const float* in[16]; float* out; unsigned char* ws; int lo, hi; };

struct P0Item { const float* W; bf16_t* WT; const float* gsc; int K, N, k0, n0; };
__device__ __forceinline__ P0Item p0_decode(const __attribute__((address_space(4))) Args* kp, int it, int l) {
    constexpr int T_IN = 448, T_A = 32, T_B = 64, T_O = 64, T_1 = 256, T_2 = 256, T_L = T_IN + T_A + T_B + T_O + T_1 + T_2;
    int r = it; unsigned char* wl = kp->ws + WS_W;
    P0Item p;
    if (r < T_IN) { p.W = kp->in[1] + (size_t)l * DM * INC; p.K = DM; p.N = INC; p.WT = (bf16_t*)(wl + WL_IN); p.gsc = kp->in[11] + l * DM; }
    else if ((r -= T_IN) < T_A) { p.W = kp->in[6] + (size_t)l * GW * DM; p.K = GW; p.N = DM; p.WT = (bf16_t*)(wl + WL_A); p.gsc = nullptr; }
    else if ((r -= T_A) < T_B) { p.W = kp->in[9] + (size_t)l * DM * DM; p.K = DM; p.N = DM; p.WT = (bf16_t*)(wl + WL_B); p.gsc = nullptr; }
    else if ((r -= T_B) < T_O) { p.W = kp->in[10] + (size_t)l * DM * DM; p.K = DM; p.N = DM; p.WT = (bf16_t*)(wl + WL_O); p.gsc = nullptr; }
    else if ((r -= T_O) < T_1) { p.W = kp->in[13] + (size_t)l * DM * DFF; p.K = DM; p.N = DFF; p.WT = (bf16_t*)(wl + WL_1); p.gsc = kp->in[12] + l * DM; }
    else { r -= T_1; p.W = kp->in[14] + (size_t)l * DFF * DM; p.K = DFF; p.N = DM; p.WT = (bf16_t*)(wl + WL_2); p.gsc = nullptr; }
    const int nblk = p.N / 256; p.k0 = 64 * (r / nblk); p.n0 = 256 * (r % nblk);
    return p;
}
constexpr int P0_NITEMS = 448 + 32 + 64 + 64 + 256 + 256;
__device__ __forceinline__ void p0_load(const P0Item& p, f32x4 (&v)[8], int wid, int lane) {
#pragma unroll
    for (int i = 0; i < 8; ++i) {
        const int kk = p.k0 + wid * 8 + i;
        f32x4 x = __builtin_nontemporal_load((const f32x4*)(p.W + (size_t)kk * p.N + p.n0 + lane * 4));
        if (p.gsc) x = x * p.gsc[kk];
        v[i] = x;
    }
}


__device__ __forceinline__ void p0_transpose_item(const float* W, int K, int N, bf16_t* WT, const float* gsc, LAS float* scr, int item, int lane) {
    const int nblk = N / 32, kb = item / nblk, nb = item % nblk, k0 = 64 * kb, n0 = 32 * nb;
#pragma unroll
    for (int i = 0; i < 32; ++i) { const int kk = 2 * i + (lane >> 5); float w = W[(size_t)(k0 + kk) * N + n0 + (lane & 31)]; if (gsc) w *= gsc[k0 + kk]; scr[kk * 33 + (lane & 31)] = w; }
    asm volatile("s_waitcnt lgkmcnt(0)" ::: "memory");
    const int c = lane & 7;
#pragma unroll
    for (int j = 0; j < 4; ++j) { const int n = (lane >> 3) + 8 * j; const LAS float* s = scr + (8 * c) * 33 + n;
        u32x4 o; o.x = cvt_pk_bf16(s[0 * 33], s[1 * 33]); o.y = cvt_pk_bf16(s[2 * 33], s[3 * 33]); o.z = cvt_pk_bf16(s[4 * 33], s[5 * 33]); o.w = cvt_pk_bf16(s[6 * 33], s[7 * 33]);
        *(u32x4*)(WT + (size_t)(n0 + n) * K + k0 + 8 * c) = o; }
    asm volatile("s_waitcnt lgkmcnt(0)" ::: "memory");
}


constexpr int GM_VZ0 = 73728, GM_VZ1 = 106496;
__device__ __forceinline__ void gmlp_dma(LAS unsigned char* L, const bf16_t* V, int R0, int g, int buf, int tid) {
    const int wu = __builtin_amdgcn_readfirstlane(tid >> 6), lane = tid & 63;
    const int base = buf ? GM_VZ1 : GM_VZ0;
#pragma unroll
    for (int i = 0; i < 4; ++i) {
        const int p = wu * 64 + i * 512 + lane, row = p >> 4, c8 = p & 15;
        __builtin_amdgcn_global_load_lds((const unsigned*)(V + (size_t)(R0 + row) * GW + g * 128 + c8 * 8), (LAS unsigned*)(L + base + (wu * 64 + i * 512) * 16), 16, 0, 0);
    }
}
__device__ __forceinline__ void gmlp_unit(LAS unsigned char* L, bf16_t* U, const bf16_t* V, const f32x2* vst, const float* Wg, const float* bsg,
                                          const float* lng, const float* lnb, int R0, int g, int tid, int buf, bool stage_w, bool has_next, int nR0, int ng_) {
    constexpr int VT = 0, WSo = 34816, MU = 69632, RSo = MU + 512;
    const int wid = tid >> 6, lane = tid & 63, fr = lane & 15, fq = lane >> 4;
    const int VZg = buf ? GM_VZ1 : GM_VZ0;
    const float gc = lng[g * 128 + (tid & 127)], bc = lnb[g * 128 + (tid & 127)], bsv = bsg[16 * wid + fr];
    if (tid < 128) {
        const f32x4* p = (const f32x4*)(vst + (size_t)(R0 + tid) * 8);
        const f32x4 a = p[0], b = p[1], c = p[2], d = p[3];
        const float s1 = (a[0] + a[2]) + (b[0] + b[2]) + (c[0] + c[2]) + (d[0] + d[2]);
        const float s2 = (a[1] + a[3]) + (b[1] + b[3]) + (c[1] + c[3]) + (d[1] + d[3]);
        const float mean = s1 * (1.0f / GW), var = fmaxf(s2 * (1.0f / GW) - mean * mean, 0.f);
        *(LAS float*)(L + MU + tid * 4) = mean; *(LAS float*)(L + RSo + tid * 4) = rsqrtf(var + EPS);
    }
    if (stage_w)
#pragma unroll
    for (int i = 0; i < 8; ++i) {
        const int p = tid + i * 512, q = p >> 5, p4 = (p & 31) * 4;
        f32x4 w = *(const f32x4*)(Wg + q * 128 + p4);
        if (q < 64 && p4 >= 64) w = (f32x4){0.f, 0.f, 0.f, 0.f};
        u32x2 o; o.x = cvt_pk_bf16(w[0], w[1]); o.y = cvt_pk_bf16(w[2], w[3]);
        *(LAS u32x2*)(L + WSo + q * 272 + p4 * 2) = o;
    }
    asm volatile("s_waitcnt vmcnt(0)" ::: "memory");
    __syncthreads();
    if (has_next) gmlp_dma(L, V, nR0, ng_, buf ^ 1, tid);
    u32x2 uq8[8];
#pragma unroll
    for (int ct = 0; ct < 8; ++ct) uq8[ct] = *(const u32x2*)(U + (size_t)(R0 + 16 * wid + fr) * GW + g * 128 + 16 * ct + 4 * fq);
    {
        const int c = tid & 127, pq = tid >> 7;
        unsigned short raw[32];
#pragma unroll
        for (int j = 0; j < 32; ++j) raw[j] = *(const LAS unsigned short*)(L + VZg + (32 * pq + j) * 256 + c * 2);
        unsigned pk[16];
#pragma unroll
        for (int j = 0; j < 32; j += 2) {
            const int p0 = 32 * pq + j;
            const float m0 = *(LAS float*)(L + MU + p0 * 4), r0 = *(LAS float*)(L + RSo + p0 * 4), m1 = *(LAS float*)(L + MU + p0 * 4 + 4), r1 = *(LAS float*)(L + RSo + p0 * 4 + 4);
            const float y0 = (bf2f(raw[j]) - m0) * r0 * gc + bc, y1 = (bf2f(raw[j + 1]) - m1) * r1 * gc + bc;
            pk[j >> 1] = cvt_pk_bf16(y0, y1);
        }
#pragma unroll
        for (int j = 0; j < 4; ++j) *(LAS u32x4*)(L + VT + c * 272 + pq * 64 + j * 16) = (u32x4){pk[4 * j], pk[4 * j + 1], pk[4 * j + 2], pk[4 * j + 3]};
    }
    __syncthreads();
    {
        bf16x8 yb[4];
#pragma unroll
        for (int ks = 0; ks < 4; ++ks) yb[ks] = *(const LAS bf16x8*)(L + WSo + (16 * wid + fr) * 272 + (ks * 32 + fq * 8) * 2);
        const int q = 16 * wid + fr;
#pragma unroll
        for (int ct = 0; ct < 8; ++ct) {
            f32x4 acc = (f32x4){0.f, 0.f, 0.f, 0.f};
#pragma unroll
            for (int ks = 0; ks < 4; ++ks) {
                const bf16x8 xa = *(const LAS bf16x8*)(L + VT + (16 * ct + fr) * 272 + (ks * 32 + fq * 8) * 2);
                acc = __builtin_amdgcn_mfma_f32_16x16x32_bf16(xa, yb[ks], acc, 0, 0, 0);
            }
            bf16_t* up = U + (size_t)(R0 + q) * GW + g * 128 + 16 * ct + 4 * fq;
            const u32x2 uq = uq8[ct];
            u32x2 o;
            o.x = cvt_pk_bf16(bf2f(uq.x & 0xffffu) * (acc[0] + bsv), bf2f(uq.x >> 16) * (acc[1] + bsv));
            o.y = cvt_pk_bf16(bf2f(uq.y & 0xffffu) * (acc[2] + bsv), bf2f(uq.y >> 16) * (acc[3] + bsv));
            *(u32x2*)up = o;
        }
    }
    __syncthreads();
}

constexpr int B1_FZ = 40960, B1_VZ = 57344;
__device__ __forceinline__ void hgrn_b1_dma(LAS unsigned char* L, const bf16_t* Fg, const bf16_t* Vg, int tid) {
    const int wid = __builtin_amdgcn_readfirstlane(tid >> 6), lane = tid & 63;
#pragma unroll
    for (int i = 0; i < 2; ++i) {
        const int p = wid * 64 + i * 512 + lane, row = p >> 4, c8 = p & 15;
        __builtin_amdgcn_global_load_lds((const unsigned*)(Fg + (size_t)row * DM + c8 * 8), (LAS unsigned*)(L + B1_FZ + (wid * 64 + i * 512) * 16), 16, 0, 0);
        __builtin_amdgcn_global_load_lds((const unsigned*)(Vg + (size_t)row * DM + c8 * 8), (LAS unsigned*)(L + B1_VZ + (wid * 64 + i * 512) * 16), 16, 0, 0);
    }
}
__device__ __forceinline__ void hgrn_b1_unit(LAS unsigned char* L, bf16_t* Sout, float* Dout, float (&sst)[8][4], float& cumdec, const float lb, int tid, bool has_next, const bf16_t* nFg, const bf16_t* nVg) {
    constexpr int KET = 0, VT = 18432, TS = 36864;
    const int wid = tid >> 6, lane = tid & 63, fr = lane & 15, fq = lane >> 4;
    const int k = tid & 127, J = tid >> 7;
    unsigned short zf[16], zv[16];
#pragma unroll
    for (int j = 0; j < 16; ++j) { zv[j] = *(const LAS unsigned short*)(L + B1_VZ + (16 * J + j) * 256 + k * 2); zf[j] = *(const LAS unsigned short*)(L + B1_FZ + (16 * J + j) * 256 + k * 2); }
    const float oml = 1.0f - lb;
    float E[16], kk[16]; float run = 1.f;
#pragma unroll
    for (int j = 0; j < 16; ++j) {
        const float z = bf2f(zf[j]), e = __expf(-z), sig = fast_rcp(1.0f + e), f = lb + oml * sig;
        kk[j] = oml * e * sig; run *= f; E[j] = run;
    }
    *(LAS float*)(L + TS + (J * 128 + k) * 4) = run;
#pragma unroll
    for (int j = 0; j < 2; ++j) {
        u32x4 w; w.x = zv[8 * j] | ((unsigned)zv[8 * j + 1] << 16); w.y = zv[8 * j + 2] | ((unsigned)zv[8 * j + 3] << 16); w.z = zv[8 * j + 4] | ((unsigned)zv[8 * j + 5] << 16); w.w = zv[8 * j + 6] | ((unsigned)zv[8 * j + 7] << 16);
        *(LAS u32x4*)(L + VT + k * 144 + J * 32 + j * 16) = w;
    }
    __syncthreads();
    if (has_next) hgrn_b1_dma(L, nFg, nVg, tid);
    const float t0 = *(LAS float*)(L + TS + k * 4), t1 = *(LAS float*)(L + TS + (128 + k) * 4), t2 = *(LAS float*)(L + TS + (256 + k) * 4), t3 = *(LAS float*)(L + TS + (384 + k) * 4);
    const float tail = (J < 1 ? t1 : 1.f) * (J < 2 ? t2 : 1.f) * (J < 3 ? t3 : 1.f);
    {
        const float rt = run * tail;
        unsigned pk[8];
#pragma unroll
        for (int j = 0; j < 16; j += 2) pk[j >> 1] = cvt_pk_bf16(kk[j] * fast_rcp(fmaxf(E[j], 1e-30f)) * rt, kk[j + 1] * fast_rcp(fmaxf(E[j + 1], 1e-30f)) * rt);
        *(LAS u32x4*)(L + KET + k * 144 + J * 32) = (u32x4){pk[0], pk[1], pk[2], pk[3]};
        *(LAS u32x4*)(L + KET + k * 144 + J * 32 + 16) = (u32x4){pk[4], pk[5], pk[6], pk[7]};
    }
    if (J == 0) { Dout[k] = cumdec; cumdec *= (t0 * t1) * (t2 * t3); }
    __syncthreads();
    {
        bf16x8 xa[2];
#pragma unroll
        for (int ks = 0; ks < 2; ++ks) xa[ks] = *(const LAS bf16x8*)(L + KET + (16 * wid + fr) * 144 + (ks * 32 + fq * 8) * 2);
        f32x4 dk = *(const LAS f32x4*)(L + TS + (16 * wid + 4 * fq) * 4);
        dk = dk * *(const LAS f32x4*)(L + TS + (128 + 16 * wid + 4 * fq) * 4); dk = dk * *(const LAS f32x4*)(L + TS + (256 + 16 * wid + 4 * fq) * 4); dk = dk * *(const LAS f32x4*)(L + TS + (384 + 16 * wid + 4 * fq) * 4);
#pragma unroll
        for (int vt = 0; vt < 8; ++vt) {
            f32x4 acc = (f32x4){0.f, 0.f, 0.f, 0.f};
#pragma unroll
            for (int ks = 0; ks < 2; ++ks) {
                const bf16x8 yb = *(const LAS bf16x8*)(L + VT + (16 * vt + fr) * 144 + (ks * 32 + fq * 8) * 2);
                acc = __builtin_amdgcn_mfma_f32_16x16x32_bf16(xa[ks], yb, acc, 0, 0, 0);
            }
            u32x2 o; o.x = cvt_pk_bf16(sst[vt][0], sst[vt][1]); o.y = cvt_pk_bf16(sst[vt][2], sst[vt][3]);
            *(u32x2*)(Sout + (size_t)(16 * vt + fr) * 128 + 16 * wid + 4 * fq) = o;
#pragma unroll
            for (int i = 0; i < 4; ++i) sst[vt][i] = dk[i] * sst[vt][i] + acc[i];
        }
    }
    asm volatile("s_waitcnt vmcnt(0)" ::: "memory");
    __syncthreads();
}

constexpr int B3_FZ = 107008, B3_QZ = 123392, B3_VZ = 86528;
__device__ __forceinline__ void hgrn_b3_dma_v(LAS unsigned char* L, const bf16_t* Vg, int tid) {
    const int wid = __builtin_amdgcn_readfirstlane(tid >> 6), lane = tid & 63;
#pragma unroll
    for (int i = 0; i < 2; ++i) {
        const int p = wid * 64 + i * 512 + lane, row = p >> 4, c8 = p & 15;
        __builtin_amdgcn_global_load_lds((const unsigned*)(Vg + (size_t)row * DM + c8 * 8), (LAS unsigned*)(L + B3_VZ + (wid * 64 + i * 512) * 16), 16, 0, 0);
    }
}
__device__ __forceinline__ void hgrn_b3_dma(LAS unsigned char* L, const bf16_t* Qg, const bf16_t* Fg, int tid) {
    const int wid = __builtin_amdgcn_readfirstlane(tid >> 6), lane = tid & 63;
#pragma unroll
    for (int i = 0; i < 2; ++i) {
        const int p = wid * 64 + i * 512 + lane, row = p >> 4, c8 = p & 15;
        __builtin_amdgcn_global_load_lds((const unsigned*)(Fg + (size_t)row * DM + c8 * 8), (LAS unsigned*)(L + B3_FZ + (wid * 64 + i * 512) * 16), 16, 0, 0);
        __builtin_amdgcn_global_load_lds((const unsigned*)(Qg + (size_t)row * DM + c8 * 8), (LAS unsigned*)(L + B3_QZ + (wid * 64 + i * 512) * 16), 16, 0, 0);
    }
}
__device__ __forceinline__ void hgrn_b3_unit(LAS unsigned char* L, bf16_t* Vg, const bf16_t* ZOg, const bf16_t* Sin, const f32x4 (&sq0)[4], const f32x4 (&sq1)[4], const float* Dc,
                                             const float lb, const float* ng, int tid, bool has_next, const bf16_t* nQg, const bf16_t* nFg, const bf16_t* nVg) {
    constexpr int QE = 0, QP = 25600, KP = 43008, VT = 86528, TS = 104960, OO = KP;
    const int wid = tid >> 6, lane = tid & 63, fr = lane & 15, fq = lane >> 4;
    bf16x8 ybS[4];
    bf16x8 pfq[4];
    constexpr int DZ = 139776;
    if (tid < 32) *(LAS f32x4*)(L + DZ + tid * 16) = *(const f32x4*)(Dc + tid * 4);
#pragma unroll
    for (int ks = 0; ks < 4; ++ks) {
        pfq[ks] = *(const bf16x8*)(Sin + (size_t)(16 * wid + fr) * 128 + ks * 32 + fq * 8);
    }
    const int te = tid >> 3, v0e = (tid & 7) * 16;
    const u32x4 z0 = *(const u32x4*)(ZOg + (size_t)te * DM + v0e), z1 = *(const u32x4*)(ZOg + (size_t)te * DM + v0e + 8);
    {
        const int k = tid & 127, J = tid >> 7;
        unsigned short zv[16], zf[16], zq[16];
#pragma unroll
        for (int j = 0; j < 16; ++j) zv[j] = *(const LAS unsigned short*)(L + B3_VZ + (16 * J + j) * 256 + k * 2);
#pragma unroll
        for (int j = 0; j < 16; ++j) { zf[j] = *(const LAS unsigned short*)(L + B3_FZ + (16 * J + j) * 256 + k * 2); zq[j] = *(const LAS unsigned short*)(L + B3_QZ + (16 * J + j) * 256 + k * 2); }
        const float oml = 1.0f - lb;
        float E[16], kk[16], qp[16]; float run = 1.f;
#pragma unroll
        for (int j = 0; j < 16; ++j) {
            const float z = bf2f(zf[j]), e = __expf(-z), sig = fast_rcp(1.0f + e), f = lb + oml * sig;
            kk[j] = oml * e * sig; run *= f; E[j] = run;
            qp[j] = bf2f(zq[j]) * run;
            *(LAS unsigned short*)(L + QP + (16 * J + j) * 272 + k * 2) = (unsigned short)(cvt_pk_bf16(qp[j], 0.f) & 0xffffu);
        }
        *(LAS float*)(L + TS + (J * 128 + k) * 4) = run;
        __syncthreads();
        if (has_next) hgrn_b3_dma(L, nQg, nFg, tid);
#pragma unroll
        for (int ks = 0; ks < 4; ++ks) {
            float v[8];
            const f32x4 d0 = *(const LAS f32x4*)(L + DZ + (ks * 32 + fq * 8) * 4), d1 = *(const LAS f32x4*)(L + DZ + (ks * 32 + fq * 8 + 4) * 4);
#pragma unroll
            for (int e = 0; e < 4; ++e) { v[e] = bf2f((unsigned)(unsigned short)pfq[ks][e]) + d0[e] * sq0[ks][e]; v[4 + e] = bf2f((unsigned)(unsigned short)pfq[ks][4 + e]) + d1[e] * sq1[ks][e]; }
            const u32x4 w = (u32x4){cvt_pk_bf16(v[0], v[1]), cvt_pk_bf16(v[2], v[3]), cvt_pk_bf16(v[4], v[5]), cvt_pk_bf16(v[6], v[7])};
            ybS[ks] = __builtin_bit_cast(bf16x8, w);
        }
#pragma unroll
        for (int j = 0; j < 2; ++j) {
            u32x4 w; w.x = zv[8 * j] | ((unsigned)zv[8 * j + 1] << 16); w.y = zv[8 * j + 2] | ((unsigned)zv[8 * j + 3] << 16); w.z = zv[8 * j + 4] | ((unsigned)zv[8 * j + 5] << 16); w.w = zv[8 * j + 6] | ((unsigned)zv[8 * j + 7] << 16);
            *(LAS u32x4*)(L + VT + k * 144 + J * 32 + j * 16) = w;
        }
        const float t0 = *(LAS float*)(L + TS + k * 4), t1 = *(LAS float*)(L + TS + (128 + k) * 4), t2 = *(LAS float*)(L + TS + (256 + k) * 4);
        const float r1 = t0, r2 = t0 * t1, r3 = r2 * t2;
        const float erj = J == 0 ? 1.f : (J == 1 ? r1 : (J == 2 ? r2 : r3));
#pragma unroll
        for (int j = 0; j < 16; ++j) *(LAS unsigned short*)(L + QE + (16 * J + j) * 400 + k * 2) = (unsigned short)(cvt_pk_bf16(qp[j] * erj, 0.f) & 0xffffu);
        {
            float kd[16], ke[16];
#pragma unroll
            for (int j = 0; j < 16; ++j) { kd[j] = kk[j] * fast_rcp(fmaxf(E[j], 1e-30f)); ke[j] = kd[j] * run; }
            const float tA = J == 0 ? t1 : t2, tB = t2;
#pragma unroll
            for (int I = 0; I < 4; ++I) {
                if (I >= J) {
                    const float gI = (I - J <= 1) ? 1.f : ((I - J == 2) ? tA : tA * tB);
                    const int base = (I == 0 ? 0 : (I == 1 ? 16 : (I == 2 ? 48 : 96))) + 16 * J;
#pragma unroll
                    for (int j = 0; j < 16; ++j) {
                        const float v = (I == J) ? kd[j] : ke[j] * gI;
                        *(LAS unsigned short*)(L + KP + (base + j) * 272 + k * 2) = (unsigned short)(cvt_pk_bf16(v, 0.f) & 0xffffu);
                    }
                }
            }
        }
    }
    __syncthreads();
#pragma unroll
    for (int rep = 0; rep < 2; ++rep) {
        const int idx = wid + 8 * rep, I = idx >> 2, Jt = idx & 3;
        u32x2 o = (u32x2){0u, 0u};
        if (Jt <= I) {
            const int base = (I == 0 ? 0 : (I == 1 ? 16 : (I == 2 ? 48 : 96))) + 16 * Jt;
            f32x4 acc = (f32x4){0.f, 0.f, 0.f, 0.f};
#pragma unroll
            for (int ks = 0; ks < 4; ++ks) {
                const bf16x8 xa = *(const LAS bf16x8*)(L + KP + (base + fr) * 272 + (ks * 32 + fq * 8) * 2);
                const bf16x8 yb = *(const LAS bf16x8*)(L + QP + (16 * I + fr) * 272 + (ks * 32 + fq * 8) * 2);
                acc = __builtin_amdgcn_mfma_f32_16x16x32_bf16(xa, yb, acc, 0, 0, 0);
            }
            if (Jt == I) {
#pragma unroll
                for (int i = 0; i < 4; ++i) if (4 * fq + i > fr) acc[i] = 0.f;
            }
            o.x = cvt_pk_bf16(acc[0], acc[1]); o.y = cvt_pk_bf16(acc[2], acc[3]);
        }
        *(LAS u32x2*)(L + QE + (16 * I + fr) * 400 + (128 + 16 * Jt + 4 * fq) * 2) = o;
    }
    __syncthreads();
    const f32x4 g0 = *(const f32x4*)(ng + v0e), g1 = *(const f32x4*)(ng + v0e + 4), g2 = *(const f32x4*)(ng + v0e + 8), g3 = *(const f32x4*)(ng + v0e + 12);
    {
        bf16x8 yb[6];
#pragma unroll
        for (int ks = 0; ks < 4; ++ks) yb[ks] = ybS[ks];
#pragma unroll
        for (int ks = 0; ks < 2; ++ks) yb[4 + ks] = *(const LAS bf16x8*)(L + VT + (16 * wid + fr) * 144 + (ks * 32 + fq * 8) * 2);
        f32x4 acc[4];
#pragma unroll
        for (int I = 0; I < 4; ++I) {
            acc[I] = (f32x4){0.f, 0.f, 0.f, 0.f};
#pragma unroll
            for (int ks = 0; ks < 6; ++ks) {
                const bf16x8 xa = *(const LAS bf16x8*)(L + QE + (16 * I + fr) * 400 + (ks * 32 + fq * 8) * 2);
                acc[I] = __builtin_amdgcn_mfma_f32_16x16x32_bf16(xa, yb[ks], acc[I], 0, 0, 0);
            }
        }
#pragma unroll
        for (int I = 0; I < 4; ++I)
#pragma unroll
            for (int i = 0; i < 4; ++i) *(LAS float*)(L + OO + (16 * I + 4 * fq + i) * 528 + (16 * wid + fr) * 4) = acc[I][i];
    }
    __syncthreads();
    if (has_next) hgrn_b3_dma_v(L, nVg, tid);
    {
        const int t = te, v0 = v0e;
        f32x4 ov[4]; float ss = 0.f;
#pragma unroll
        for (int j = 0; j < 4; ++j) { ov[j] = *(const LAS f32x4*)(L + OO + t * 528 + (v0 + 4 * j) * 4); ss += (ov[j][0] * ov[j][0] + ov[j][1] * ov[j][1]) + (ov[j][2] * ov[j][2] + ov[j][3] * ov[j][3]); }
        ss += __shfl_xor(ss, 1); ss += __shfl_xor(ss, 2); ss += __shfl_xor(ss, 4);
        const float rstd = rsqrtf(ss * (1.0f / 128.0f) + EPS);
        u32x4 w0, w1;
        w0.x = cvt_pk_bf16(ov[0][0] * rstd * g0[0] * bf2f(z0.x & 0xffffu), ov[0][1] * rstd * g0[1] * bf2f(z0.x >> 16));
        w0.y = cvt_pk_bf16(ov[0][2] * rstd * g0[2] * bf2f(z0.y & 0xffffu), ov[0][3] * rstd * g0[3] * bf2f(z0.y >> 16));
        w0.z = cvt_pk_bf16(ov[1][0] * rstd * g1[0] * bf2f(z0.z & 0xffffu), ov[1][1] * rstd * g1[1] * bf2f(z0.z >> 16));
        w0.w = cvt_pk_bf16(ov[1][2] * rstd * g1[2] * bf2f(z0.w & 0xffffu), ov[1][3] * rstd * g1[3] * bf2f(z0.w >> 16));
        w1.x = cvt_pk_bf16(ov[2][0] * rstd * g2[0] * bf2f(z1.x & 0xffffu), ov[2][1] * rstd * g2[1] * bf2f(z1.x >> 16));
        w1.y = cvt_pk_bf16(ov[2][2] * rstd * g2[2] * bf2f(z1.y & 0xffffu), ov[2][3] * rstd * g2[3] * bf2f(z1.y >> 16));
        w1.z = cvt_pk_bf16(ov[3][0] * rstd * g3[0] * bf2f(z1.z & 0xffffu), ov[3][1] * rstd * g3[1] * bf2f(z1.z >> 16));
        w1.w = cvt_pk_bf16(ov[3][2] * rstd * g3[2] * bf2f(z1.w & 0xffffu), ov[3][3] * rstd * g3[3] * bf2f(z1.w >> 16));
        *(u32x4*)(Vg + (size_t)t * DM + v0) = w0; *(u32x4*)(Vg + (size_t)t * DM + v0 + 8) = w1;
    }
    asm volatile("s_waitcnt vmcnt(0)" ::: "memory");
    __syncthreads();
}


#define XB_TMO      128
#define XB_XCNT(j)  (256  + 64 * (j))
#define XB_XSUB(j)  (1280 + 64 * (j))
#define XB_XGEN(j)  (2304 + 64 * (j))
#define XB_TOP      3328
#define XB_TOPGEN   3392
#define XCD_BAR_WORDS 3456
#define XB_SPIN_CAP (1u << 22)
__device__ __forceinline__ unsigned xb_ld(unsigned* p)              { return __hip_atomic_load(p, __ATOMIC_RELAXED, __HIP_MEMORY_SCOPE_AGENT); }
__device__ __forceinline__ unsigned xb_add(unsigned* p, unsigned v) { return __hip_atomic_fetch_add(p, v, __ATOMIC_RELAXED, __HIP_MEMORY_SCOPE_AGENT); }
__device__ __forceinline__ unsigned xb_xcc_id() { return (unsigned)__builtin_amdgcn_s_getreg((3 << 11) | 20) & 0xFu; }
#define XB_SPIN(cond, bar) do { unsigned _sp = 0; while (cond) { __builtin_amdgcn_s_sleep(1); \
    if ((++_sp & 255u) == 0u) { if (xb_ld(&(bar)[XB_TMO])) break; if (_sp > XB_SPIN_CAP) { atomicAdd(&(bar)[XB_TMO], 1u); break; } } } } while (0)
struct XcdBarrier { unsigned* bar; unsigned x; volatile LAS unsigned* st; };
__device__ __forceinline__ XcdBarrier xcd_barrier_post(unsigned* bar, volatile LAS unsigned* st) {
    XcdBarrier b; b.bar = bar; b.x = xb_xcc_id(); b.st = st;
    if (threadIdx.x == 0) (void)xb_add(&bar[XB_XCNT(b.x)], 1u);
    return b;
}
__device__ __forceinline__ void xcd_barrier_complete(unsigned* bar, unsigned x, unsigned& nloc, unsigned& nx) {
    const unsigned G = gridDim.x * gridDim.y * gridDim.z;
    unsigned sum, cnt, mine, sp = 0u;
    for (;;) {
        sum = 0u; cnt = 0u; mine = 0u;
#pragma unroll
        for (unsigned j = 0; j < 16; ++j) { const unsigned c = xb_ld(&bar[XB_XCNT(j)]); sum += c; cnt += (c > 0u) ? 1u : 0u; mine = (j == x) ? c : mine; }
        if (sum == G) break;
        __builtin_amdgcn_s_sleep(1);
        if ((++sp & 255u) == 0u) { if (xb_ld(&bar[XB_TMO])) break; if (sp > XB_SPIN_CAP) { atomicAdd(&bar[XB_TMO], 1u); break; } }
    }
    nloc = mine > 0u ? mine : 1u; nx = cnt > 0u ? cnt : 1u;
}
__device__ __forceinline__ void xcd_barrier(const XcdBarrier& b) {
    asm volatile("s_waitcnt vmcnt(0)" ::: "memory");
    __syncthreads();
    if (threadIdx.x == 0) {
        unsigned* bar = b.bar;
        __builtin_amdgcn_s_waitcnt(0);
        unsigned nloc = b.st[0], nx = b.st[1];
        if (nloc == 0u) { xcd_barrier_complete(bar, b.x, nloc, nx); b.st[0] = nloc; b.st[1] = nx; }
        const unsigned old = xb_add(&bar[XB_XSUB(b.x)], 1u);
        const unsigned gen = old / nloc;
        if (old + 1u == (gen + 1u) * nloc) {
            __builtin_amdgcn_fence(__ATOMIC_RELEASE, "agent");
            asm volatile("s_waitcnt vmcnt(0)" ::: "memory");
            const unsigned og = xb_add(&bar[XB_TOP], 1u);
            const unsigned tg = og / nx;
            if (og + 1u == (tg + 1u) * nx) xb_add(&bar[XB_TOPGEN], 1u);
            else XB_SPIN(xb_ld(&bar[XB_TOPGEN]) == tg, bar);
            __builtin_amdgcn_fence(__ATOMIC_ACQUIRE, "agent");
            xb_add(&bar[XB_XGEN(b.x)], 1u);
            asm volatile("s_waitcnt vmcnt(0)" ::: "memory");
        } else {
            XB_SPIN(xb_ld(&bar[XB_XGEN(b.x)]) == gen, bar);
            __builtin_amdgcn_fence(__ATOMIC_ACQUIRE, "agent");
            asm volatile("s_waitcnt vmcnt(0)" ::: "memory");
        }
    }
    __syncthreads();
}
constexpr size_t WS_BAR = 65536;

__global__ void __launch_bounds__(512, 2) mega_fwd(Args a) {
    unsigned char* ap_ws = a.ws;
    __shared__ __attribute__((aligned(16))) unsigned char lds_raw[LDS_BYTES];
    LAS unsigned char* L = (LAS unsigned char*)lds_raw;
    cg::grid_group grid = cg::this_grid();
    volatile LAS unsigned* bst = (volatile LAS unsigned*)(L + LDS_BYTES - 16);
    if (threadIdx.x < 2) bst[threadIdx.x] = 0u;
    __syncthreads();
    (void)xcd_barrier_post((unsigned*)(ap_ws + WS_BAR), bst);
    const int st_hi = a.hi;
    for (int st = a.lo; st < st_hi; ++st) {
        const __attribute__((address_space(4))) Args* kp = (const __attribute__((address_space(4))) Args*)__builtin_amdgcn_kernarg_segment_ptr();
        asm volatile("" : "+s"(kp));
        if (st != 0 && st != 9 && st != 18 && (st - 1 - (st > 9 ? 9 : 0)) == 2) continue;
#define a (*kp)
        int tid = threadIdx.x; asm volatile("" : "+v"(tid));
        int bx = blockIdx.x; asm volatile("" : "+s"(bx));
        int G = gridDim.x; asm volatile("" : "+s"(G));
        const int lane = tid & 63, wave = __builtin_amdgcn_readfirstlane(tid >> 6);
        unsigned char* ws = a.ws;
        const float* x_in = a.in[0];
        float* lbv = (float*)(ws + WS_LBV);
        bf16_t* XB = (bf16_t*)(ws + WS_XB); float* SSP = (float*)(ws + WS_SSP);
        unsigned char* P = ws + WS_P;
        bf16_t *bU = (bf16_t*)(P + P_U), *bV = (bf16_t*)(P + P_V), *bQ = (bf16_t*)(P + P_Q), *bF = (bf16_t*)(P + P_F), *bI = (bf16_t*)(P + P_I), *bZO = (bf16_t*)(P + P_ZO),
               *bS = (bf16_t*)a.out  , *MIX = bQ  ;
        const unsigned char *bGA = P + P_GA, *bGB = P + P_GB;
        f32x2* bVST = (f32x2*)(P + P_VST); float* bD = (float*)(P + P_D);
        bf16_t* H1 = (bf16_t*)(ws + WS_H1);
        if (st >= 100) {
#ifdef DBG_OFF
            const bf16_t* src = (const bf16_t*)(ws + (size_t)DBG_OFF);
            for (size_t i = (size_t)bx * 512 + tid; i < (size_t)MTOT * DM; i += (size_t)G * 512) a.out[i] = bf2f(src[i]);
#endif
        } else if (st == 0 || st == 9) {
            const int wlayer = st == 0 ? 0 : 1;
            const int gw = bx * 8 + wave, NGW = G * 8;
            {
                LAS float* T = (LAS float*)L;
                f32x4 v[8];
                int it = bx;
                { const P0Item p = p0_decode(kp, it < P0_NITEMS ? it : P0_NITEMS - 1, wlayer); p0_load(p, v, wave, lane); }
                while (it < P0_NITEMS) {
                    const P0Item p = p0_decode(kp, it, wlayer);
#pragma unroll
                    for (int i = 0; i < 8; ++i)
#pragma unroll
                        for (int e = 0; e < 4; ++e) T[(wave * 8 + i) * 257 + lane * 4 + e] = v[i][e];
                    __syncthreads();
                    const int nx = it + G;
                    if (nx < P0_NITEMS) { const P0Item q = p0_decode(kp, nx, wlayer); p0_load(q, v, wave, lane); }
#pragma unroll
                    for (int j = 0; j < 4; ++j) {
                        const int q = tid + j * 512, n = q >> 3, c = q & 7;
                        const LAS float* t = T + (8 * c) * 257 + n;
                        u32x4 o; o.x = cvt_pk_bf16(t[0], t[257]); o.y = cvt_pk_bf16(t[2 * 257], t[3 * 257]); o.z = cvt_pk_bf16(t[4 * 257], t[5 * 257]); o.w = cvt_pk_bf16(t[6 * 257], t[7 * 257]);
                        *(u32x4*)(p.WT + (size_t)(p.n0 + n) * p.K + p.k0 + 8 * c) = o;
                    }
                    __syncthreads();
                    it = nx;
                }
            }
            const int m_end = st == 0 ? MTOT : 0;
            for (int m0 = gw; m0 < m_end; m0 += 4 * NGW) {
                f32x4 v[4][4];
#pragma unroll
                for (int r = 0; r < 4; ++r) {
                    const int m = m0 + r * NGW < MTOT ? m0 + r * NGW : m0;
                    const f32x4* xr = (const f32x4*)(x_in + (size_t)m * DM) + lane;
#pragma unroll
                    for (int j = 0; j < 4; ++j) v[r][j] = __builtin_nontemporal_load(&xr[64 * j]);
                }
#pragma unroll
                for (int r = 0; r < 4; ++r) {
                    const int m = m0 + r * NGW;
                    float sq = 0.f;
#pragma unroll
                    for (int j = 0; j < 4; ++j) sq += (v[r][j][0] * v[r][j][0] + v[r][j][1] * v[r][j][1]) + (v[r][j][2] * v[r][j][2] + v[r][j][3] * v[r][j][3]);
                    sq = wave_sum(sq);
                    if (m < MTOT) {
                        u32x2* o8 = (u32x2*)(XB + (size_t)m * DM) + lane;
#pragma unroll
                        for (int j = 0; j < 4; ++j) o8[64 * j] = (u32x2){cvt_pk_bf16(v[r][j][0], v[r][j][1]), cvt_pk_bf16(v[r][j][2], v[r][j][3])};
                        if (lane == 0) *(f32x4*)(SSP + (size_t)m * 4) = (f32x4){sq, 0.f, 0.f, 0.f};
                    }
                }
            }
            for (int i = bx * 512 + tid; i < (st == 0 ? 2048 : 0); i += G * 512) {
                const int c = i & 1023;
                lbv[i] = (i < 1024) ? 0.f : fast_rcp(1.0f + __expf(a.in[7][c] - a.in[7][1024 + c]));
            }
        } else if (st == 18) {
            const int gw = bx * 8 + wave, NGW = G * 8;
            const float* fn = a.in[15];
            f32x4 gq[4];
#pragma unroll
            for (int j = 0; j < 4; ++j) gq[j] = *((const f32x4*)fn + 64 * j + lane);
            for (int m0 = gw; m0 < MTOT; m0 += 4 * NGW) {
                u32x2 xv[4][4]; f32x4 pp[4];
#pragma unroll
                for (int r = 0; r < 4; ++r) {
                    const int m = m0 + r * NGW < MTOT ? m0 + r * NGW : m0;
                    const u32x2* xr = (const u32x2*)(XB + (size_t)m * DM) + lane;
#pragma unroll
                    for (int j = 0; j < 4; ++j) xv[r][j] = __builtin_nontemporal_load(&xr[64 * j]);
                    pp[r] = *(const f32x4*)(SSP + (size_t)m * 4);
                }
#pragma unroll
                for (int r = 0; r < 4; ++r) {
                    const int m = m0 + r * NGW;
                    if (m < MTOT) {
                        const float rstd = rstd4(pp[r]);
                        f32x4* orow = (f32x4*)(a.out + (size_t)m * DM) + lane;
#pragma unroll
                        for (int j = 0; j < 4; ++j) {
                            const f32x4 v = (f32x4){bf2f(xv[r][j].x & 0xffffu), bf2f(xv[r][j].x >> 16), bf2f(xv[r][j].y & 0xffffu), bf2f(xv[r][j].y >> 16)};
                            __builtin_nontemporal_store(v * rstd * gq[j], &orow[64 * j]);
                        }
                    }
                }
            }
        } else {
            const int l = st > 9 ? 1 : 0, k = st - 1 - 9 * l;
            unsigned char* wl = ws + WS_W;
            if (k < 5) {
                const int kind = k;
                if (kind == 0) {
                    pg8::Gemm g{XB, (const bf16_t*)(wl + WL_IN), MTOT, INC, DM};
                    pg8::StaticOrder S; S.init(MTOT, INC, G, bx);
                    EpiInProj E{SSP, P, bVST};

#ifndef NO_P1
                    for (int rep_ = 0; rep_ < DUP_P1; ++rep_) { pg8::gemm_phase<EpiInProj>(L, g, S, E, tid); asm volatile("s_waitcnt vmcnt(0)" ::: "memory"); __syncthreads(); }
#endif

                } else if (kind == 1) {
                    {
                        if (bx < 1024) gmlp_dma(L, bV, (bx >> 2) * 128, bx & 3, 0, tid);
                        int par = 0, gprev = -1;
                        for (int u = bx; u < 1024; u += G) {
                            const int g = u & 3, blk = u >> 2;
                            const int un = u + G; const bool hn = un < 1024;
                            gmlp_unit(L, bU, bV, bVST, a.in[4] + (size_t)(l * 4 + g) * 16384, a.in[5] + (l * 4 + g) * 128, a.in[2] + l * GW, a.in[3] + l * GW, blk * 128, g, tid,
                                      par, g != gprev, hn, (un >> 2) * 128, un & 3);
                            par ^= 1; gprev = g;
                        }
                    }
                    for (int sg = bx; sg < 256; sg += G) {
                        const int bh = sg >> 2, seg = sg & 3, hh = bh & 7, bl = bh >> 3, c0 = seg * 16;
                        const size_t toff0 = (size_t)(bl * SEQ + c0 * 64) * DM + hh * 128;
                        hgrn_b1_dma(L, bF + toff0, bI + toff0, tid);
                        asm volatile("s_waitcnt vmcnt(0)" ::: "memory");
                        __syncthreads();
                        float sst[8][4]; float cumdec = 1.f;
                        const float lb1 = lbv[l * 1024 + hh * 128 + (tid & 127)];
#pragma unroll
                        for (int vt = 0; vt < 8; ++vt)
#pragma unroll
                            for (int i = 0; i < 4; ++i) sst[vt][i] = 0.f;
                        for (int i = 0; i < 16; ++i) {
                            const int u = bh * 64 + c0 + i; const bool hn = i < 15;
                            const size_t toffn = toff0 + (size_t)(hn ? i + 1 : i) * 64 * DM;
                            hgrn_b1_unit(L, bS + (size_t)u * 16384, bD + (size_t)u * 128, sst, cumdec, lb1, tid, hn, bF + toffn, bI + toffn);
                        }
                        {
                            const int wid = tid >> 6, fr = tid & 15, fq = (tid & 63) >> 4;
                            float* sb = (float*)(P + P_SEGB) + (size_t)sg * 16384;
#pragma unroll
                            for (int vt = 0; vt < 8; ++vt) *(f32x4*)(sb + (size_t)(16 * vt + fr) * 128 + 16 * wid + 4 * fq) = (f32x4){sst[vt][0], sst[vt][1], sst[vt][2], sst[vt][3]};
                            if (tid < 128) ((float*)(P + P_SEGA))[(size_t)sg * 128 + tid] = cumdec;
                        }
                    }
                } else if (kind == 2) {
                } else if (kind == 3) {
                    for (int sg = bx; sg < 256; sg += G) {
                        const int wid = tid >> 6, fr = tid & 15, fq = (tid & 63) >> 4;
                        const int bh = sg >> 2, seg = sg & 3, hh = bh & 7, bl = bh >> 3, c0 = seg * 16;
                        const size_t toff0 = (size_t)(bl * SEQ + c0 * 64) * DM + hh * 128;
                        hgrn_b3_dma(L, bQ + toff0, bF + toff0, tid);
                        hgrn_b3_dma_v(L, bI + toff0, tid);
                        f32x4 sq0[4], sq1[4];
                        {
                            float z_ = 0.f; asm volatile("" : "+v"(z_));
#pragma unroll
                            for (int ks = 0; ks < 4; ++ks) { sq0[ks] = (f32x4){z_, z_, z_, z_}; sq1[ks] = (f32x4){z_, z_, z_, z_}; }
                            for (int j = 0; j < seg; ++j) {
                                const float* sbj = (const float*)(P + P_SEGB) + (size_t)(bh * 4 + j) * 16384 + (size_t)(16 * wid + fr) * 128 + fq * 8;
                                const float* saj = (const float*)(P + P_SEGA) + (size_t)(bh * 4 + j) * 128 + fq * 8;
#pragma unroll
                                for (int ks = 0; ks < 4; ++ks) {
                                    sq0[ks] = *(const f32x4*)(saj + ks * 32) * sq0[ks] + *(const f32x4*)(sbj + ks * 32);
                                    sq1[ks] = *(const f32x4*)(saj + ks * 32 + 4) * sq1[ks] + *(const f32x4*)(sbj + ks * 32 + 4);
                                }
                            }
                        }
                        const float lb3 = lbv[l * 1024 + hh * 128 + (tid & 127)];
                        asm volatile("s_waitcnt vmcnt(0)" ::: "memory");
                        __syncthreads();
                        for (int i = 0; i < 16; ++i) {
                            const int u = bh * 64 + c0 + i; const bool hn = i < 15;
                            const size_t toff = toff0 + (size_t)i * 64 * DM, toffn = toff0 + (size_t)(hn ? i + 1 : i) * 64 * DM;
                            hgrn_b3_unit(L, bI + toff, bZO + toff, bS + (size_t)u * 16384, sq0, sq1, bD + (size_t)u * 128, lb3, a.in[8] + l * 128, tid, hn, bQ + toffn, bF + toffn, bI + toffn);
                        }
                    }
                } else {
                    for (int pass = 0; pass < 2; ++pass) {
                        pg8::Gemm g{pass == 0 ? bU : bI, (const bf16_t*)(wl + (pass == 0 ? WL_A : WL_B)), MTOT, DM, pass == 0 ? GW : DM};
                        pg8::StaticOrder S; S.init(MTOT, DM, G, bx);
                        EpiMix E{pass == 0 ? bGA : bGB, MIX, pass == 0 ? 1 : 0};

#ifndef NO_P3
                        pg8::gemm_phase<EpiMix>(L, g, S, E, tid);
#endif

                    }
                }
            } else if (k == 5 || k == 7) {
                pg8::Gemm g{k == 5 ? MIX : H1, (const bf16_t*)(wl + (k == 5 ? WL_O : WL_2)), MTOT, DM, k == 5 ? DM : DFF};
                pg8::StaticOrder S; S.init(MTOT, DM, G, bx);
                EpiResid E{XB, SSP, L + 131072};

#ifndef NO_P4
                pg8::gemm_phase<EpiResid>(L, g, S, E, tid);
#endif

            } else {
                pg8::Gemm g{XB, (const bf16_t*)(wl + WL_1), MTOT, DFF, DM};
                pg8::StaticOrder S; S.init(MTOT, DFF, G, bx);
                EpiFF1 E{SSP, H1};

#ifndef NO_P5
                pg8::gemm_phase<EpiFF1>(L, g, S, E, tid);
#endif

            }
        }
#undef a
        if (st + 1 < st_hi) {
            if (st_hi > 1000) grid.sync();
            else { XcdBarrier xbar; xbar.bar = (unsigned*)(kp->ws + WS_BAR); xbar.x = xb_xcc_id(); xbar.st = (volatile LAS unsigned*)(L + LDS_BYTES - 16); xcd_barrier(xbar); }
        }
    }
}

extern "C" void kernel_launch(void* const* d_in, const int* in_sizes, int n_in, void* d_out, int out_size, void* d_ws, size_t ws_size, hipStream_t stream) {
    static int grid = 0;
    if (grid == 0) {
        if (n_in != 16 || out_size != MTOT * DM || ws_size < WS_END) { fprintf(stderr, "kernel_launch: unexpected shapes / workspace (%d inputs, out %d, ws %zu < %zu)\n", n_in, out_size, ws_size, (size_t)WS_END); grid = -1; return; }
        int dev = 0, cus = 0, per_cu = 0;
        hipGetDevice(&dev); hipDeviceGetAttribute(&cus, hipDeviceAttributeMultiprocessorCount, dev);
        hipOccupancyMaxActiveBlocksPerMultiprocessor(&per_cu, (const void*)mega_fwd, 512, 0);
        (void)hipGetLastError();
        if (per_cu < 1) per_cu = 1;
        grid = cus * 1;
        if (grid <= 0) grid = 256;
    }
    if (grid < 0) return;
    (void)hipMemsetAsync((char*)d_ws + WS_BAR, 0, 16384, stream);
    Args a{};
    for (int i = 0; i < 16; ++i) a.in[i] = (const float*)d_in[i];
    a.out = (float*)d_out; a.ws = (unsigned char*)d_ws;
#if MK_MULTI
#ifdef DBG_STOP
    for (int st = 0; st < DBG_STOP; ++st) { a.lo = st; a.hi = st + 1; hipLaunchKernelGGL(mega_fwd, dim3(grid), dim3(512), 0, stream, a); }
    a.lo = 100; a.hi = 101; hipLaunchKernelGGL(mega_fwd, dim3(grid), dim3(512), 0, stream, a);
#else
    for (int st = 0; st < 19; ++st) { a.lo = st; a.hi = st + 1; hipLaunchKernelGGL(mega_fwd, dim3(grid), dim3(512), 0, stream, a); }
#endif
#else
    a.lo = 0; a.hi = 19;
    void* args[] = {&a};
    hipError_t e = hipLaunchCooperativeKernel((const void*)mega_fwd, dim3(grid), dim3(512), args, 0, stream);
    if (e != hipSuccess) fprintf(stderr, "cooperative launch failed: %s (grid %d)\n", hipGetErrorString(e), grid);
#endif
}
```
